# Optimizing an MI355X kernel written in HIP

```python
import jax, jax.numpy as jnp
from jax import lax
import numpy as np

D_MODEL = 1024
BATCH = 4
SEQ = 8192
DEPTH = 2

PLE_DIM = 256
MLA_HEADS = 8
MLA_NOPE = 64
MLA_ROPE = 32
MLA_V = 64
MLA_QK = MLA_NOPE + MLA_ROPE
MLA_Q_LORA = 384
MLA_KV_LORA = 128
ROPE_THETA = 10000.0
Q_BLOCK = 128
FNET_GROUPS = 4
GQA_Q_HEADS = 8
GQA_KV_HEADS = 2
GQA_GROUP = GQA_Q_HEADS // GQA_KV_HEADS
GQA_HEAD_DIM = 64
WINDOW = 128
WIN_BLOCK = 128
FFN_DIM = -(-8 * D_MODEL // (3 * 256)) * 256
RMS_EPS = 1e-6

IN_SPLITS = (MLA_Q_LORA, MLA_KV_LORA, MLA_ROPE,
             GQA_Q_HEADS * GQA_HEAD_DIM, GQA_KV_HEADS * GQA_HEAD_DIM, GQA_KV_HEADS * GQA_HEAD_DIM,
             D_MODEL, D_MODEL, D_MODEL)
IN_COLS = sum(IN_SPLITS)

kernel_name = 'hybrid_mla_fnet_swagqa_encoder'


def rms_norm(x, gain):
    xf = x.astype(jnp.float32)
    y = xf * lax.rsqrt(jnp.mean(xf * xf, axis=-1, keepdims=True) + RMS_EPS)
    return (y * gain.astype(jnp.float32)).astype(x.dtype)


def apply_rope(t, positions):
    half = t.shape[-1] // 2
    inv_freq = ROPE_THETA ** (-jnp.arange(half, dtype=jnp.float32) / half)
    ang = positions.astype(jnp.float32)[..., None] * inv_freq
    ang = ang.reshape(ang.shape[:2] + (1,) * (t.ndim - 3) + (half,))
    cos, sin = jnp.cos(ang), jnp.sin(ang)
    tf = t.astype(jnp.float32)
    t1, t2 = tf[..., :half], tf[..., half:]
    return jnp.concatenate([t1 * cos - t2 * sin, t1 * sin + t2 * cos], axis=-1).astype(t.dtype)


def alibi_slopes(n_heads):
    return 2.0 ** (-8.0 * (np.arange(n_heads, dtype=np.float32) + 1.0) / n_heads)


def mla_attention(c_q, c_kv, k_rope, positions, q_norm, w_uq, kv_norm, w_ukv):
    B, S, _ = c_q.shape
    q = (rms_norm(c_q, q_norm) @ w_uq).reshape(B, S, MLA_HEADS, MLA_QK)
    q_nope = q[..., :MLA_NOPE]
    q_rope = apply_rope(q[..., MLA_NOPE:], positions)
    kv = (rms_norm(c_kv, kv_norm) @ w_ukv).reshape(B, S, MLA_HEADS, MLA_NOPE + MLA_V)
    k_nope, v = kv[..., :MLA_NOPE], kv[..., MLA_NOPE:]
    k_r = apply_rope(k_rope, positions)
    scale = MLA_QK ** -0.5
    nb = S // Q_BLOCK
    qn_b = q_nope.reshape(B, nb, Q_BLOCK, MLA_HEADS, MLA_NOPE).transpose(1, 0, 2, 3, 4)
    qr_b = q_rope.reshape(B, nb, Q_BLOCK, MLA_HEADS, MLA_ROPE).transpose(1, 0, 2, 3, 4)

    def attend(blk):
        qn, qr = blk
        s = (jnp.einsum('bqhd,bkhd->bhqk', qn, k_nope)
             + jnp.einsum('bqhr,bkr->bhqk', qr, k_r)).astype(jnp.float32) * scale
        probs = jax.nn.softmax(s, axis=-1).astype(v.dtype)
        return jnp.einsum('bhqk,bkhd->bqhd', probs, v)

    o = lax.map(attend, (qn_b, qr_b))
    return o.transpose(1, 0, 2, 3, 4).reshape(B, S, MLA_HEADS * MLA_V)


def fourier_mix(h):
    B, S, D = h.shape
    hg = h.astype(jnp.float32).reshape(B, S, FNET_GROUPS, D // FNET_GROUPS)
    f = jnp.fft.fftn(hg, axes=(1, 3), norm='ortho').real
    return f.reshape(B, S, D).astype(h.dtype)


def windowed_gqa(q, k, v, positions, sink):
    B, S, _ = q.shape
    nb = S // WIN_BLOCK
    q = q.reshape(B, nb, WIN_BLOCK, GQA_KV_HEADS, GQA_GROUP, GQA_HEAD_DIM)
    k = k.reshape(B, S, GQA_KV_HEADS, GQA_HEAD_DIM)
    v = v.reshape(B, S, GQA_KV_HEADS, GQA_HEAD_DIM)

    def windows(t):
        pad = ((0, 0), (WIN_BLOCK, WIN_BLOCK)) + ((0, 0),) * (t.ndim - 2)
        tb = jnp.pad(t, pad).reshape((B, nb + 2, WIN_BLOCK) + t.shape[2:])
        return jnp.concatenate([tb[:, :-2], tb[:, 1:-1], tb[:, 2:]], axis=2)

    kw, vw, pw = windows(k), windows(v), windows(positions)
    scale = GQA_HEAD_DIM ** -0.5
    s = jnp.einsum('bnqhgd,bnkhd->bnhgqk', q, kw).astype(jnp.float32) * scale
    pq = positions.reshape(B, nb, WIN_BLOCK)
    dist = jnp.abs(pq[..., :, None] - pw[..., None, :]).astype(jnp.float32)
    slopes = jnp.asarray(alibi_slopes(GQA_Q_HEADS)).reshape(GQA_KV_HEADS, GQA_GROUP)
    s = s - slopes[None, None, :, :, None, None] * dist[:, :, None, None]
    qi = jnp.arange(WIN_BLOCK)
    kj = jnp.arange(3 * WIN_BLOCK)
    band = jnp.abs(kj[None, :] - WIN_BLOCK - qi[:, None]) <= WINDOW
    key_idx = jnp.arange(nb)[:, None] * WIN_BLOCK - WIN_BLOCK + kj[None, :]
    valid = (key_idx >= 0) & (key_idx < S)
    mask = band[None] & valid[:, None, :]
    s = jnp.where(mask[None, :, None, None], s, -jnp.inf)
    sink_l = sink.astype(jnp.float32).reshape(GQA_KV_HEADS, GQA_GROUP)[None, None, :, :, None, None]
    m = jnp.maximum(jnp.max(s, axis=-1, keepdims=True), sink_l)
    e = jnp.exp(s - m)
    probs = (e / (jnp.sum(e, axis=-1, keepdims=True) + jnp.exp(sink_l - m))).astype(v.dtype)
    o = jnp.einsum('bnhgqk,bnkhd->bnqhgd', probs, vw)
    return o.reshape(B, S, GQA_Q_HEADS * GQA_HEAD_DIM)


def setup_inputs(seed: int = 0) -> dict:
    key = jax.random.key(seed)
    ks = iter(jax.random.split(key, 32))

    def w(shape, fan_in):
        return jax.random.normal(next(ks), shape, jnp.float32) * (fan_in ** -0.5)

    def gain(n):
        return 1.0 + 0.1 * jax.random.normal(next(ks), (DEPTH, n), jnp.float32)

    x = jax.random.normal(next(ks), (BATCH, SEQ, D_MODEL), jnp.float32)
    p = jax.random.normal(next(ks), (DEPTH, BATCH, SEQ, PLE_DIM), jnp.float32)
    offset = jax.random.randint(next(ks), (BATCH, 1), 0, 4096, jnp.int32)
    positions = (offset + jnp.arange(SEQ, dtype=jnp.int32)[None, :]).astype(jnp.int32)
    return {
        'x': x,
        'p': p,
        'positions': positions,
        'norm_mix_pre': gain(D_MODEL),
        'w_in': w((DEPTH, D_MODEL, IN_COLS), D_MODEL),
        'mla_q_norm': gain(MLA_Q_LORA),
        'w_uq': w((DEPTH, MLA_Q_LORA, MLA_HEADS * MLA_QK), MLA_Q_LORA),
        'mla_kv_norm': gain(MLA_KV_LORA),
        'w_ukv': w((DEPTH, MLA_KV_LORA, MLA_HEADS * (MLA_NOPE + MLA_V)), MLA_KV_LORA),
        'gqa_sink': 0.5 * jax.random.normal(next(ks), (DEPTH, GQA_Q_HEADS), jnp.float32),
        'w_branch_a': w((DEPTH, MLA_HEADS * MLA_V, D_MODEL), MLA_HEADS * MLA_V),
        'w_branch_b': w((DEPTH, D_MODEL, D_MODEL), D_MODEL),
        'w_branch_c': w((DEPTH, GQA_Q_HEADS * GQA_HEAD_DIM, D_MODEL), GQA_Q_HEADS * GQA_HEAD_DIM),
        'w_out': w((DEPTH, D_MODEL, D_MODEL), D_MODEL),
        'norm_mix_post': gain(D_MODEL),
        'norm_ffn_pre': gain(D_MODEL),
        'w_ffn_gate': w((DEPTH, D_MODEL, FFN_DIM), D_MODEL),
        'w_ffn_up': w((DEPTH, D_MODEL, FFN_DIM), D_MODEL),
        'w_ffn_down': w((DEPTH, FFN_DIM, D_MODEL), FFN_DIM),
        'norm_ffn_post': gain(D_MODEL),
        'w_ple_proj': w((DEPTH, PLE_DIM, D_MODEL), PLE_DIM),
        'w_ple_gate': w((DEPTH, D_MODEL, D_MODEL), D_MODEL),
        'norm_ple': gain(D_MODEL),
    }


def reference(x, p, positions, norm_mix_pre, w_in, mla_q_norm, w_uq, mla_kv_norm, w_ukv,
              gqa_sink, w_branch_a, w_branch_b, w_branch_c, w_out, norm_mix_post,
              norm_ffn_pre, w_ffn_gate, w_ffn_up, w_ffn_down, norm_ffn_post,
              w_ple_proj, w_ple_gate, norm_ple):
    split_points = list(np.cumsum(IN_SPLITS)[:-1])
    for i in range(DEPTH):
        h = rms_norm(x, norm_mix_pre[i])
        z = h @ w_in[i]
        c_q, c_kv, k_rope, q_c, k_c, v_c, g_a, g_b, g_c = jnp.split(z, split_points, axis=-1)
        o_a = mla_attention(c_q, c_kv, k_rope, positions, mla_q_norm[i], w_uq[i],
                            mla_kv_norm[i], w_ukv[i])
        o_b = fourier_mix(h)
        o_c = windowed_gqa(q_c, k_c, v_c, positions, gqa_sink[i])
        merged = (jax.nn.sigmoid(g_a) * (o_a @ w_branch_a[i])
                  + jax.nn.sigmoid(g_b) * (o_b @ w_branch_b[i])
                  + jax.nn.sigmoid(g_c) * (o_c @ w_branch_c[i]))
        x = x + rms_norm(merged @ w_out[i], norm_mix_post[i])
        h = rms_norm(x, norm_ffn_pre[i])
        ff = (jax.nn.silu(h @ w_ffn_gate[i]) * (h @ w_ffn_up[i])) @ w_ffn_down[i]
        x = x + rms_norm(ff, norm_ffn_post[i])
        e = (p[i] @ w_ple_proj[i]) * jax.nn.sigmoid(x @ w_ple_gate[i])
        x = x + rms_norm(e, norm_ple[i])
    return x
```

```cpp
#include <hip/hip_runtime.h>
#include <hip/hip_cooperative_groups.h>
#include <cstdio>
namespace cg = cooperative_groups;

#define DI __device__ __forceinline__
typedef unsigned short u16;
typedef short bf16x8 __attribute__((ext_vector_type(8)));
typedef short s16x4 __attribute__((ext_vector_type(4)));
typedef float f32x4 __attribute__((ext_vector_type(4)));
typedef float f32x16 __attribute__((ext_vector_type(16)));
typedef float f2v __attribute__((ext_vector_type(2)));
typedef __bf16 b2v __attribute__((ext_vector_type(2)));

constexpr int NTOK = 32768, DM = 1024, SEQ = 8192, NB = 4;
constexpr int INC = 4384, ZS = 1312, FFN = 2816, PLE = 256;
constexpr int NTHR = 512;
constexpr float EPS = 1e-6f;
constexpr float LOG2E = 1.4426950408889634f;

constexpr size_t W_IN = 0;
constexpr size_t W_UQ = W_IN + (size_t)INC * 1024;
constexpr size_t W_UKV = W_UQ + 768 * 384;
constexpr size_t W_A = W_UKV + 1024 * 128;
constexpr size_t W_B = W_A + 1024 * 512;
constexpr size_t W_C = W_B + 1024 * 1024;
constexpr size_t W_OUT = W_C + 1024 * 512;
constexpr size_t W_FG = W_OUT + 1024 * 1024;
constexpr size_t W_FU = W_FG + (size_t)FFN * 1024;
constexpr size_t W_FD = W_FU + (size_t)FFN * 1024;
constexpr size_t W_PLE = W_FD + (size_t)FFN * 1024;
constexpr size_t W_PG = W_PLE + 1024 * 256;
constexpr size_t W_LAYER = W_PG + 1024 * 1024;
constexpr int WT_ITEMS_LAYER = 1104 + 72 + 32 + 128 + 256 + 128 + 256 + 704 + 704 + 704 + 64 + 256;

constexpr size_t MiB = 1ull << 20;
constexpr size_t OFF_W = 0;
constexpr size_t OFF_E1 = 69 * MiB;
constexpr size_t OFF_E2 = OFF_E1 + 512 * 256 * 2;
constexpr size_t OFF_E3 = OFF_E2 + 256 * 256 * 2;
constexpr size_t OFF_CNT = 69 * MiB + 4 * MiB + 512 * 1024;
constexpr size_t OFF_ROPE = 74 * MiB;
constexpr size_t OFF_PB = 78 * MiB;
constexpr size_t OFF_H = 110 * MiB;
constexpr size_t OFF_OA = 174 * MiB;
constexpr size_t OFF_OC = 206 * MiB;
constexpr size_t OFF_R = 238 * MiB;
constexpr size_t WS_NEED = OFF_R + 256 * MiB;
constexpr size_t R_ZS = OFF_R;
constexpr size_t R_QM = OFF_R + 82 * MiB;
constexpr size_t R_KF = OFF_R + 130 * MiB;
constexpr size_t R_VT = OFF_R + 178 * MiB;
constexpr size_t R_VTC = OFF_R + 210 * MiB;
constexpr size_t R_YT = OFF_R;
constexpr size_t R_TP = OFF_R + 128 * MiB;
constexpr size_t R_OB = OFF_R;
constexpr size_t R_GATE = OFF_R + 64 * MiB;
constexpr size_t R_Y = OFF_R + 192 * MiB;
constexpr size_t R_HID = OFF_R;
constexpr size_t R_FF = OFF_R + 176 * MiB;
constexpr size_t R_E = OFF_R;

constexpr int LDS_ROW = 144;
constexpr int LDS_A = 256 * 128;
constexpr int LDS_B = 256 * 128;
constexpr int LDS_STAGE = LDS_A + LDS_B;
constexpr int LDS_STG3 = LDS_A + 128 * 128;
constexpr int LDS_AUX = 3 * LDS_STG3;
constexpr int LDS_CTL = LDS_AUX + 1024;
constexpr int LDS_BYTES = LDS_CTL + 64;

struct Params {
  const float* in[23];
  const int* pos;
  float* out;
  unsigned char* ws;
  int ph_lo, ph_hi;
};

DI int otid() { int t = threadIdx.x; asm volatile("" : "+v"(t)); return t; }
DI int xcd_lin(int v) { return (v & ~255) | ((v & 7) << 5) | ((v >> 3) & 31); }
template <int GM> DI void tile_of(int L, int TN, int& pm, int& pn) { const int nig = GM * TN, gid = L / nig, w = L % nig; pm = gid * GM + (w % GM); pn = w / GM; }
DI unsigned pk2(float a, float b) { f2v v = {a, b}; b2v r = __builtin_convertvector(v, b2v); return __builtin_bit_cast(unsigned, r); }
DI u16 f2bf(float a) { return (u16)(pk2(a, 0.f) & 0xffffu); }
DI float bflo(unsigned u) { return __uint_as_float(u << 16); }
DI float bfhi(unsigned u) { return __uint_as_float(u & 0xffff0000u); }
DI float bf2f(u16 v) { return __uint_as_float(((unsigned)v) << 16); }
DI float fexp2(float x) { return __builtin_amdgcn_exp2f(x); }
DI float frcp(float x) { return __builtin_amdgcn_rcpf(x); }
DI float fsigmoid(float x) { return frcp(1.f + fexp2(-x * LOG2E)); }
DI float cos_rev(float r) { return __builtin_amdgcn_cosf(r); }
DI float sin_rev(float r) { return __builtin_amdgcn_sinf(r); }
DI float wave_sum(float v) {
#pragma unroll
  for (int o = 32; o >= 1; o >>= 1) v += __shfl_xor(v, o, 64);
  return v;
}
DI uint2 pk4(f32x4 v) { uint2 r; r.x = pk2(v[0], v[1]); r.y = pk2(v[2], v[3]); return r; }

template <int MT, int NT, bool SWAP, bool PIPE = true, class ARow = void>
DI void gemm_main(f32x4 (&acc)[MT][NT], ARow arow, int m0, const u16* __restrict__ Bt, int ldb, int n0, int K, char* smem) {
  static_assert(MT == 2 || MT == 4, "MT");
  static_assert(NT == 2 || NT == 4 || NT == 8, "NT");
  typedef __attribute__((address_space(3))) unsigned int lds_u32;
  const int tid = otid(), lane = tid & 63;
  const int wave = __builtin_amdgcn_readfirstlane(tid >> 6);
  const int wm = wave >> 1, wn = wave & 1;
  const int srow = wave * 8 + (lane >> 3);
  const int schunk = (lane & 7) ^ (((wave & 1) * 4 + (lane >> 4)) & 7);
  const u16* pa0 = arow(m0 + srow) + schunk * 8;
  const u16* pa1 = arow(m0 + srow + 64) + schunk * 8;
  const u16* pa2 = MT > 2 ? arow(m0 + srow + 128) + schunk * 8 : pa0;
  const u16* pa3 = MT > 2 ? arow(m0 + srow + 192) + schunk * 8 : pa0;
  const u16* pb0 = Bt + (size_t)(n0 + srow) * ldb + schunk * 8;
  const u16* pb1 = NT > 2 ? Bt + (size_t)(n0 + srow + 64) * ldb + schunk * 8 : pb0;
  const u16* pb2 = NT > 4 ? Bt + (size_t)(n0 + srow + 128) * ldb + schunk * 8 : pb0;
  const u16* pb3 = NT > 4 ? Bt + (size_t)(n0 + srow + 192) * ldb + schunk * 8 : pb0;
  const int nk = K >> 6;
  lds_u32* lbase = (lds_u32*)(smem);
  const int wofs = wave * 1024;
#define G_LDS(p, byteoff) __builtin_amdgcn_global_load_lds((const unsigned int*)(p), (lds_u32*)((__attribute__((address_space(3))) char*)lbase + (byteoff)), 16, 0, 0)
#define G_STAGE(stg, k0)                                                           \
  do {                                                                             \
    const int so_ = (stg) * STG + wofs;                                            \
    G_LDS(pa0 + (k0), so_);                                                        \
    G_LDS(pa1 + (k0), so_ + 8192);                                                 \
    if (MT > 2) { G_LDS(pa2 + (k0), so_ + 16384); G_LDS(pa3 + (k0), so_ + 24576); } \
    G_LDS(pb0 + (k0), so_ + LDS_A);                                                \
    if (NT > 2) G_LDS(pb1 + (k0), so_ + LDS_A + 8192);                             \
    if (NT > 4) { G_LDS(pb2 + (k0), so_ + LDS_A + 16384); G_LDS(pb3 + (k0), so_ + LDS_A + 24576); } \
  } while (0)
  constexpr bool RING3 = NT <= 4;
  constexpr int STG = RING3 ? LDS_STG3 : LDS_STAGE;
  constexpr int NLD = MT + NT / 2;
#define G_WAIT_PREV()                                                                                  \
  do {                                                                                                 \
    if (!RING3) asm volatile("s_waitcnt vmcnt(0)" ::: "memory");                                       \
    else if (NLD == 4) asm volatile("s_waitcnt vmcnt(4)" ::: "memory");                                \
    else if (NLD == 5) asm volatile("s_waitcnt vmcnt(5)" ::: "memory");                                \
    else asm volatile("s_waitcnt vmcnt(6)" ::: "memory");                                              \
    asm volatile("s_waitcnt lgkmcnt(0)" ::: "memory");                                                 \
    __builtin_amdgcn_s_barrier();                                                                      \
    asm volatile("" ::: "memory");                                                                     \
  } while (0)
  static_assert(!RING3 || NLD == 4 || NLD == 5 || NLD == 6, "NLD");
  G_STAGE(0, 0);
  if (RING3) G_STAGE(1, (nk > 1 ? 1 : 0) << 6);
  G_WAIT_PREV();
  const int xq = ((lane >> 4) ^ ((lane & 15) >> 1)) * 16;
  const int fa_off = (wm * 16 * MT + (lane & 15)) * 128;
  const int fb_off = LDS_A + (wn * 16 * NT + (lane & 15)) * 128;
  int scur = 0;
  for (int kt = 0; kt < nk; ++kt) {
    const bool pf = RING3 ? (kt + 2 < nk) : (kt + 1 < nk);
    if (pf) {
      if (RING3) { const int s2 = scur == 0 ? 2 : scur - 1; G_STAGE(s2, (kt + 2) << 6); }
      else G_STAGE(scur ^ 1, (kt + 1) << 6);
    }
    __builtin_amdgcn_sched_barrier(0);
    const char* sb = smem + scur * STG;
    if (!PIPE) {
#pragma unroll
      for (int ks = 0; ks < 2; ++ks) {
        const int xo = xq ^ (ks * 64);
        bf16x8 af[MT], bfr[NT];
#pragma unroll
        for (int i = 0; i < MT; ++i) af[i] = *(const bf16x8*)(sb + fa_off + i * 2048 + xo);
#pragma unroll
        for (int j = 0; j < NT; ++j) bfr[j] = *(const bf16x8*)(sb + fb_off + j * 2048 + xo);
#pragma unroll
        for (int i = 0; i < MT; ++i)
#pragma unroll
          for (int j = 0; j < NT; ++j) {
            if (SWAP) acc[i][j] = __builtin_amdgcn_mfma_f32_16x16x32_bf16(bfr[j], af[i], acc[i][j], 0, 0, 0);
            else acc[i][j] = __builtin_amdgcn_mfma_f32_16x16x32_bf16(af[i], bfr[j], acc[i][j], 0, 0, 0);
          }
      }
    } else {
      constexpr int JG = NT < 4 ? NT : 4;
      constexpr int NG = NT / JG, NSTEP = 2 * NG;
      bf16x8 afr[2][MT], bgr[2][JG];
#pragma unroll
      for (int i = 0; i < MT; ++i) afr[0][i] = *(const bf16x8*)(sb + fa_off + i * 2048 + xq);
#pragma unroll
      for (int j = 0; j < JG; ++j) bgr[0][j] = *(const bf16x8*)(sb + fb_off + j * 2048 + xq);
#pragma unroll
      for (int t = 0; t < NSTEP; ++t) {
        const int ks = t / NG, jg = (t % NG) * JG;
        if (t + 1 < NSTEP) {
          const int ks1 = (t + 1) / NG, jg1 = ((t + 1) % NG) * JG;
          const int xo1 = xq ^ (ks1 * 64);
          if (ks1 != ks) {
#pragma unroll
            for (int i = 0; i < MT; ++i) afr[ks1 & 1][i] = *(const bf16x8*)(sb + fa_off + i * 2048 + xo1);
          }
#pragma unroll
          for (int j = 0; j < JG; ++j) bgr[(t + 1) & 1][j] = *(const bf16x8*)(sb + fb_off + (jg1 + j) * 2048 + xo1);
        }
        __builtin_amdgcn_sched_barrier(0);
#pragma unroll
        for (int i = 0; i < MT; ++i)
#pragma unroll
          for (int j = 0; j < JG; ++j) {
            if (SWAP) acc[i][jg + j] = __builtin_amdgcn_mfma_f32_16x16x32_bf16(bgr[t & 1][j], afr[ks & 1][i], acc[i][jg + j], 0, 0, 0);
            else acc[i][jg + j] = __builtin_amdgcn_mfma_f32_16x16x32_bf16(afr[ks & 1][i], bgr[t & 1][j], acc[i][jg + j], 0, 0, 0);
          }
      }
    }
    __builtin_amdgcn_sched_barrier(0);
    if (pf) G_WAIT_PREV();
    else {
      asm volatile("s_waitcnt vmcnt(0)" ::: "memory");
      asm volatile("s_waitcnt lgkmcnt(0)" ::: "memory");
      __builtin_amdgcn_s_barrier();
      asm volatile("" ::: "memory");
    }
    scur = RING3 ? (scur == 2 ? 0 : scur + 1) : (scur ^ 1);
  }
#undef G_WAIT_PREV
#undef G_LDS
#undef G_STAGE
}

template <int MT, int NT>
DI void zero_acc(f32x4 (&acc)[MT][NT]) {
#pragma unroll
  for (int i = 0; i < MT; ++i)
#pragma unroll
    for (int j = 0; j < NT; ++j) acc[i][j] = f32x4{0.f, 0.f, 0.f, 0.f};
}

template <int MT, int NT, bool SWAP, class F>
DI void gemm_epi(f32x4 (&acc)[MT][NT], int m0, int n0, F f) {
  const int tid_ = otid(); const int lane = tid_ & 63, wave = tid_ >> 6;
  const int wm = wave >> 1, wn = wave & 1;
#pragma unroll
  for (int i = 0; i < MT; ++i)
#pragma unroll
    for (int j = 0; j < NT; ++j) {
      int m, n;
      if (SWAP) { m = m0 + wm * 16 * MT + i * 16 + (lane & 15); n = n0 + wn * 16 * NT + j * 16 + (lane >> 4) * 4; }
      else { m = m0 + wm * 16 * MT + i * 16 + (lane >> 4) * 4; n = n0 + wn * 16 * NT + j * 16 + (lane & 15); }
      f(m, n, acc[i][j], i, j);
    }
}

struct RowLin {
  const u16* base; int ld;
  DI const u16* operator()(int m) const { return base + (size_t)m * ld; }
};

namespace pg8 {
#define PG8_LAS __attribute__((address_space(3)))
constexpr int BM = 256, BK = 64, HALF = 128, HTB = HALF * BK * 2;
DI int lds_byte(int r, int c) { const int st = (r >> 4) * 2 + (c >> 5), rr = r & 15, cc = c & 31, ob = rr * 64 + cc * 2; return st * 1024 + (ob ^ (((ob >> 9) & 1) << 5)); }
DI void stage_rc(int b, int& R, int& C) { const int st = b / 1024, sb = b % 1024, swz = sb ^ (((sb >> 9) & 1) << 5); R = (st >> 1) * 16 + swz / 64; C = (st & 1) * 32 + (swz % 64) / 2; }
struct Unit { int pm, pn; };
struct Gemm { const u16* A; const u16* Bt; int lda, ldb, K; };
template <int GM> struct Order {
  int nN, nunits, G, c;
  DI bool next(int i, Unit& u) const {
    const int L = c + i * G;
    if (L >= nunits) return false;
    tile_of<GM>(L, nN, u.pm, u.pn);
    return true;
  }
};
template <class Epi, class Sched>
DI void gemm_phase(PG8_LAS unsigned char* lds, const Gemm g, const Sched& S, const Epi& E) {
  const int tid = otid(), wid = __builtin_amdgcn_readfirstlane(tid >> 6), lane = tid & 63, wr = wid >> 2, wc = wid & 3, fr = lane & 15, fq = lane >> 4;
  const int K = g.K, nt = K / BK;
  unsigned voffA[2], voffB[2];
#pragma unroll
  for (int i = 0; i < 2; ++i) { int R, C; stage_rc(tid * 16 + i * 8192, R, C); voffA[i] = (unsigned)(R * g.lda + C) * 2u; voffB[i] = (unsigned)(R * g.ldb + C) * 2u; }
  const size_t kstep = (size_t)(BK * 2);
  const size_t hstepA = (size_t)HALF * g.lda * 2, hstepB = (size_t)HALF * g.ldb * 2;
  const size_t tstepA = 2 * hstepA, tstepB = 2 * hstepB;
  const unsigned ldsw = (unsigned)wid * 1024u;
  const int aoff = lds_byte(wr * 64 + fr, fq * 8), boff = lds_byte(wc * 32 + fr, fq * 8);
#define PG8_SA(b, h) (((b) * 2 + (h)) * HTB)
#define PG8_SB(b, h) ((4 + (b) * 2 + (h)) * HTB)
#define PG8_STAGE(bufoff, gbase, voff) do { _Pragma("unroll") for (int _i = 0; _i < 2; ++_i) \
        __builtin_amdgcn_global_load_lds((const unsigned*)((const char*)(gbase) + (voff)[_i]), (PG8_LAS unsigned*)(lds + (bufoff) + ldsw + _i * 8192), 16, 0, 0); } while (0)
#define PG8_LDA(dst, b, h) do { _Pragma("unroll") for (int m = 0; m < 4; ++m) _Pragma("unroll") for (int k = 0; k < 2; ++k) dst[m][k] = *(const PG8_LAS bf16x8*)(lds + PG8_SA(b, h) + aoff + m * 2048 + k * 1024); } while (0)
#define PG8_LDB(dst, b, h) do { _Pragma("unroll") for (int n = 0; n < 2; ++n) _Pragma("unroll") for (int k = 0; k < 2; ++k) dst[n][k] = *(const PG8_LAS bf16x8*)(lds + PG8_SB(b, h) + boff + n * 2048 + k * 1024); } while (0)
#define PG8_MMA(ai, bj, At, Bt) do { __builtin_amdgcn_s_setprio(1); _Pragma("unroll") for (int m = 0; m < 4; ++m) _Pragma("unroll") for (int n = 0; n < 2; ++n) _Pragma("unroll") for (int k = 0; k < 2; ++k) \
        acc[ai][bj][m][n] = __builtin_amdgcn_mfma_f32_16x16x32_bf16(Bt[n][k], At[m][k], acc[ai][bj][m][n], 0, 0, 0); __builtin_amdgcn_s_setprio(0); } while (0)
#define PG8_WAIT_V(n) asm volatile("s_waitcnt vmcnt(" #n ")" ::: "memory")
#define PG8_WAIT_L(n) asm volatile("s_waitcnt lgkmcnt(" #n ")" ::: "memory")
#define PG8_BAR __builtin_amdgcn_s_barrier()
#define PG8_SCHED __builtin_amdgcn_sched_barrier(0)
  Unit cur, nxt; int ui = 0;
  if (!S.next(0, cur)) return;
  f32x4 acc[2][2][4][2];
#pragma unroll
  for (int a = 0; a < 2; ++a)
#pragma unroll
    for (int b = 0; b < 2; ++b)
#pragma unroll
      for (int m = 0; m < 4; ++m)
#pragma unroll
        for (int n = 0; n < 2; ++n) acc[a][b][m][n] = (f32x4){0.f, 0.f, 0.f, 0.f};
  bf16x8 At[4][2], B0[2][2], B1[2][2];
  const char* cA = (const char*)g.A + (size_t)cur.pm * tstepA; const char* cB = (const char*)g.Bt + (size_t)cur.pn * tstepB;
  PG8_STAGE(PG8_SB(0, 0), cB, voffB); PG8_STAGE(PG8_SA(0, 0), cA, voffA); PG8_STAGE(PG8_SB(0, 1), cB + hstepB, voffB); PG8_STAGE(PG8_SA(0, 1), cA + hstepA, voffA);
  if (wr == 1) PG8_BAR;
  PG8_WAIT_V(4); PG8_BAR;
  PG8_STAGE(PG8_SB(1, 0), cB + kstep, voffB); PG8_STAGE(PG8_SA(1, 0), cA + kstep, voffA); PG8_STAGE(PG8_SB(1, 1), cB + hstepB + kstep, voffB);
  PG8_WAIT_V(6); PG8_BAR;
  for (;;) {
    const bool has_next = S.next(ui + 1, nxt);
    const char* nA = has_next ? (const char*)g.A + (size_t)nxt.pm * tstepA : cA; const char* nB = has_next ? (const char*)g.Bt + (size_t)nxt.pn * tstepB : cB;
    for (int t = 0; t < nt; t += 2) {
      const bool last = (t == nt - 2);
      const char* a1 = cA + (size_t)(t + 1) * kstep;
      const char* a2 = last ? nA : cA + (size_t)(t + 2) * kstep; const char* b2 = last ? nB : cB + (size_t)(t + 2) * kstep;
      const char* a3 = a2 + kstep; const char* b3 = b2 + kstep;
      PG8_LDB(B0, 0, 0); PG8_SCHED; PG8_LDA(At, 0, 0); PG8_STAGE(PG8_SA(1, 1), a1 + hstepA, voffA);
      PG8_WAIT_L(8); PG8_BAR; PG8_WAIT_L(0); PG8_MMA(0, 0, At, B0); PG8_BAR; PG8_SCHED;
      PG8_LDB(B1, 0, 1); PG8_STAGE(PG8_SB(0, 0), b2, voffB);
      PG8_BAR; PG8_WAIT_L(0); PG8_MMA(0, 1, At, B1); PG8_BAR;
      PG8_LDA(At, 0, 1); PG8_STAGE(PG8_SA(0, 0), a2, voffA);
      PG8_BAR; PG8_WAIT_L(0); PG8_MMA(1, 0, At, B0); PG8_BAR; PG8_SCHED;
      PG8_STAGE(PG8_SB(0, 1), b2 + hstepB, voffB);
      PG8_WAIT_V(6); PG8_BAR; PG8_MMA(1, 1, At, B1); PG8_BAR;
      PG8_LDB(B0, 1, 0); PG8_SCHED; PG8_LDA(At, 1, 0); PG8_STAGE(PG8_SA(0, 1), a2 + hstepA, voffA);
      PG8_WAIT_L(8); PG8_BAR; PG8_WAIT_L(0); PG8_MMA(0, 0, At, B0); PG8_BAR; PG8_SCHED;
      PG8_LDB(B1, 1, 1); PG8_STAGE(PG8_SB(1, 0), b3, voffB);
      PG8_BAR; PG8_WAIT_L(0); PG8_MMA(0, 1, At, B1); PG8_BAR;
      PG8_LDA(At, 1, 1); PG8_STAGE(PG8_SA(1, 0), a3, voffA);
      PG8_BAR; PG8_WAIT_L(0); PG8_MMA(1, 0, At, B0); PG8_BAR; PG8_SCHED;
      PG8_STAGE(PG8_SB(1, 1), b3 + hstepB, voffB);
      PG8_WAIT_V(6); PG8_BAR; PG8_MMA(1, 1, At, B1); PG8_BAR;
    }
    E(acc, cur, wr, wc, fr, fq);
    if (!has_next) break;
#pragma unroll
    for (int a = 0; a < 2; ++a)
#pragma unroll
      for (int b = 0; b < 2; ++b)
#pragma unroll
        for (int m = 0; m < 4; ++m)
#pragma unroll
          for (int n = 0; n < 2; ++n) acc[a][b][m][n] = (f32x4){0.f, 0.f, 0.f, 0.f};
    cur = nxt; cA = nA; cB = nB; ++ui;
  }
  PG8_WAIT_V(0);
  if (wr == 0) PG8_BAR;
  PG8_BAR;
#undef PG8_SA
#undef PG8_SB
#undef PG8_STAGE
#undef PG8_LDA
#undef PG8_LDB
#undef PG8_MMA
#undef PG8_WAIT_V
#undef PG8_WAIT_L
#undef PG8_BAR
#undef PG8_SCHED
}
struct EpiStore {
  u16* C; int ldc;
  DI void operator()(const f32x4 (&acc)[2][2][4][2], const Unit& u, int wr, int wc, int fr, int fq) const {
#pragma unroll
    for (int ai = 0; ai < 2; ++ai)
#pragma unroll
      for (int m = 0; m < 4; ++m) {
        u16* rowp = C + (size_t)(u.pm * BM + ai * HALF + wr * 64 + m * 16 + fr) * ldc + u.pn * BM + wc * 32 + 4 * fq;
#pragma unroll
        for (int bj = 0; bj < 2; ++bj)
#pragma unroll
          for (int n = 0; n < 2; ++n) *(uint2*)(rowp + bj * HALF + n * 16) = pk4(acc[ai][bj][m][n]);
      }
  }
};
struct EpiSwiGLU {
  u16* C; int ldc;
  DI void operator()(const f32x4 (&acc)[2][2][4][2], const Unit& u, int wr, int wc, int fr, int fq) const {
#pragma unroll
    for (int ai = 0; ai < 2; ++ai)
#pragma unroll
      for (int m = 0; m < 4; ++m) {
        u16* rowp = C + (size_t)(u.pm * BM + ai * HALF + wr * 64 + m * 16 + fr) * ldc + u.pn * HALF + wc * 32 + 4 * fq;
#pragma unroll
        for (int n = 0; n < 2; ++n) {
          const f32x4 gv = acc[ai][0][m][n], uv = acc[ai][1][m][n];
          f32x4 r;
#pragma unroll
          for (int q = 0; q < 4; ++q) r[q] = gv[q] * fsigmoid(gv[q]) * uv[q];
          *(uint2*)(rowp + n * 16) = pk4(r);
        }
      }
  }
};
struct EpiZs {
  u16* zs; u16* vtc;
  DI void operator()(const f32x4 (&acc)[2][2][4][2], const Unit& u, int wr, int wc, int fr, int fq) const {
#pragma unroll
    for (int ai = 0; ai < 2; ++ai)
#pragma unroll
      for (int m = 0; m < 4; ++m) {
        const int row = u.pm * BM + ai * HALF + wr * 64 + m * 16 + fr;
#pragma unroll
        for (int bj = 0; bj < 2; ++bj)
#pragma unroll
          for (int n = 0; n < 2; ++n) {
            const int col = u.pn * BM + bj * HALF + wc * 32 + n * 16 + 4 * fq;
            const f32x4 v = acc[ai][bj][m][n];
            if (col < 1184) {
              *(uint2*)(zs + (size_t)row * ZS + col) = pk4(v);
            } else if (col < ZS) {
              const int c = col - 1184, kvh = c >> 6, d = c & 63, b = row >> 13, s = row & 8191;
              u16* q = vtc + ((size_t)(b * 2 + kvh) * 64 + d) * SEQ + s;
              q[0] = f2bf(v[0]); q[SEQ] = f2bf(v[1]); q[2 * SEQ] = f2bf(v[2]); q[3 * SEQ] = f2bf(v[3]);
            }
          }
      }
  }
};
struct EpiE2 {
  u16* tp;
  DI void operator()(const f32x4 (&acc)[2][2][4][2], const Unit& u, int wr, int wc, int fr, int fq) const {
#pragma unroll
    for (int ai = 0; ai < 2; ++ai)
#pragma unroll
      for (int m = 0; m < 4; ++m) {
        const int tr = ai * HALF + wr * 64 + m * 16 + fr, comp = tr >> 7, k1 = tr & 127;
#pragma unroll
        for (int bj = 0; bj < 2; ++bj)
#pragma unroll
          for (int n = 0; n < 2; ++n) {
            const int R = u.pn * BM + bj * HALF + wc * 32 + n * 16 + 4 * fq;
            *(uint2*)(tp + ((size_t)(R >> 6) * 128 + k1) * 128 + comp * 64 + (R & 63)) = pk4(acc[ai][bj][m][n]);
          }
      }
  }
};
struct EpiSigmoid {
  u16* C; int ldc;
  DI void operator()(const f32x4 (&acc)[2][2][4][2], const Unit& u, int wr, int wc, int fr, int fq) const {
#pragma unroll
    for (int ai = 0; ai < 2; ++ai)
#pragma unroll
      for (int m = 0; m < 4; ++m) {
        u16* rowp = C + (size_t)(u.pm * BM + ai * HALF + wr * 64 + m * 16 + fr) * ldc + u.pn * BM + wc * 32 + 4 * fq;
#pragma unroll
        for (int bj = 0; bj < 2; ++bj)
#pragma unroll
          for (int n = 0; n < 2; ++n) {
            const f32x4 v = acc[ai][bj][m][n];
            f32x4 r;
#pragma unroll
            for (int q = 0; q < 4; ++q) r[q] = fsigmoid(v[q]);
            *(uint2*)(rowp + bj * HALF + n * 16) = pk4(r);
          }
      }
  }
};
}

DI void rowpass(int row, const float* __restrict__ xf, const u16* xb, const u16* __restrict__ y, const float* __restrict__ gy,
                float* __restrict__ xdf, u16* xdb, const float* __restrict__ go, u16* outn) {
  const int lane = otid() & 63;
  float x[16];
  if (xf) {
#pragma unroll
    for (int i = 0; i < 4; ++i) {
      float4 v = *(const float4*)(xf + (size_t)row * DM + i * 256 + lane * 4);
      x[i * 4 + 0] = v.x; x[i * 4 + 1] = v.y; x[i * 4 + 2] = v.z; x[i * 4 + 3] = v.w;
    }
  } else {
#pragma unroll
    for (int i = 0; i < 4; ++i) {
      uint2 u = *(const uint2*)(xb + (size_t)row * DM + i * 256 + lane * 4);
      x[i * 4 + 0] = bflo(u.x); x[i * 4 + 1] = bfhi(u.x); x[i * 4 + 2] = bflo(u.y); x[i * 4 + 3] = bfhi(u.y);
    }
  }
  if (y) {
    float yv[16];
    float ss = 0.f;
#pragma unroll
    for (int i = 0; i < 4; ++i) {
      uint2 u = *(const uint2*)(y + (size_t)row * DM + i * 256 + lane * 4);
      yv[i * 4 + 0] = bflo(u.x); yv[i * 4 + 1] = bfhi(u.x); yv[i * 4 + 2] = bflo(u.y); yv[i * 4 + 3] = bfhi(u.y);
    }
#pragma unroll
    for (int i = 0; i < 16; ++i) ss += yv[i] * yv[i];
    ss = wave_sum(ss);
    const float rs = rsqrtf(ss * (1.f / DM) + EPS);
#pragma unroll
    for (int i = 0; i < 4; ++i) {
      float4 g = *(const float4*)(gy + i * 256 + lane * 4);
      x[i * 4 + 0] += yv[i * 4 + 0] * rs * g.x; x[i * 4 + 1] += yv[i * 4 + 1] * rs * g.y;
      x[i * 4 + 2] += yv[i * 4 + 2] * rs * g.z; x[i * 4 + 3] += yv[i * 4 + 3] * rs * g.w;
    }
  }
  if (xdf) {
#pragma unroll
    for (int i = 0; i < 4; ++i) {
      float4 v = {x[i * 4 + 0], x[i * 4 + 1], x[i * 4 + 2], x[i * 4 + 3]};
      *(float4*)(xdf + (size_t)row * DM + i * 256 + lane * 4) = v;
    }
  }
  float rs = 1.f;
  if (outn && go) {
    float ss = 0.f;
#pragma unroll
    for (int i = 0; i < 16; ++i) ss += x[i] * x[i];
    ss = wave_sum(ss);
    rs = rsqrtf(ss * (1.f / DM) + EPS);
  }
  if (xdb) {
#pragma unroll
    for (int i = 0; i < 4; ++i) {
      uint2 u;
      u.x = pk2(x[i * 4 + 0], x[i * 4 + 1]);
      u.y = pk2(x[i * 4 + 2], x[i * 4 + 3]);
      *(uint2*)(xdb + (size_t)row * DM + i * 256 + lane * 4) = u;
    }
  }
  if (outn) {
#pragma unroll
    for (int i = 0; i < 4; ++i) {
      float4 g = {1.f, 1.f, 1.f, 1.f};
      if (go) g = *(const float4*)(go + i * 256 + lane * 4);
      uint2 u;
      u.x = pk2(x[i * 4 + 0] * rs * g.x, x[i * 4 + 1] * rs * g.y);
      u.y = pk2(x[i * 4 + 2] * rs * g.z, x[i * 4 + 3] * rs * g.w);
      *(uint2*)(outn + (size_t)row * DM + i * 256 + lane * 4) = u;
    }
  }
}

DI void rowpass_pipe(int row, int stride, int nrows, const u16* xb, const u16* __restrict__ y, const float* __restrict__ gy,
                     float* __restrict__ xdf, u16* xdb, const float* __restrict__ go, u16* outn) {
  const int lane = otid() & 63;
  if (row >= nrows) return;
  uint2 cx0, cx1, cx2, cx3, cy0, cy1, cy2, cy3;
#define RP_LOAD(r_, x0, x1, x2, x3, y0, y1, y2, y3)                          \
  do {                                                                       \
    const u16* xp_ = xb + (size_t)(r_) * DM + lane * 4;                      \
    const u16* yp_ = y + (size_t)(r_) * DM + lane * 4;                       \
    x0 = *(const uint2*)(xp_); x1 = *(const uint2*)(xp_ + 256);             \
    x2 = *(const uint2*)(xp_ + 512); x3 = *(const uint2*)(xp_ + 768);       \
    y0 = *(const uint2*)(yp_); y1 = *(const uint2*)(yp_ + 256);             \
    y2 = *(const uint2*)(yp_ + 512); y3 = *(const uint2*)(yp_ + 768);       \
  } while (0)
  RP_LOAD(row, cx0, cx1, cx2, cx3, cy0, cy1, cy2, cy3);
  for (; row < nrows; row += stride) {
    const int rn = row + stride < nrows ? row + stride : row;
    uint2 nx0, nx1, nx2, nx3, ny0, ny1, ny2, ny3;
    RP_LOAD(rn, nx0, nx1, nx2, nx3, ny0, ny1, ny2, ny3);
    asm volatile("" ::: "memory");
    __builtin_amdgcn_sched_barrier(0);
    float x[16], yv[16];
    x[0] = bflo(cx0.x); x[1] = bfhi(cx0.x); x[2] = bflo(cx0.y); x[3] = bfhi(cx0.y);
    x[4] = bflo(cx1.x); x[5] = bfhi(cx1.x); x[6] = bflo(cx1.y); x[7] = bfhi(cx1.y);
    x[8] = bflo(cx2.x); x[9] = bfhi(cx2.x); x[10] = bflo(cx2.y); x[11] = bfhi(cx2.y);
    x[12] = bflo(cx3.x); x[13] = bfhi(cx3.x); x[14] = bflo(cx3.y); x[15] = bfhi(cx3.y);
    yv[0] = bflo(cy0.x); yv[1] = bfhi(cy0.x); yv[2] = bflo(cy0.y); yv[3] = bfhi(cy0.y);
    yv[4] = bflo(cy1.x); yv[5] = bfhi(cy1.x); yv[6] = bflo(cy1.y); yv[7] = bfhi(cy1.y);
    yv[8] = bflo(cy2.x); yv[9] = bfhi(cy2.x); yv[10] = bflo(cy2.y); yv[11] = bfhi(cy2.y);
    yv[12] = bflo(cy3.x); yv[13] = bfhi(cy3.x); yv[14] = bflo(cy3.y); yv[15] = bfhi(cy3.y);
    float ss = 0.f;
#pragma unroll
    for (int i = 0; i < 16; ++i) ss += yv[i] * yv[i];
    ss = wave_sum(ss);
    const float rsy = rsqrtf(ss * (1.f / DM) + EPS);
#pragma unroll
    for (int i = 0; i < 4; ++i) {
      float4 g = *(const float4*)(gy + i * 256 + lane * 4);
      x[i * 4 + 0] += yv[i * 4 + 0] * rsy * g.x; x[i * 4 + 1] += yv[i * 4 + 1] * rsy * g.y;
      x[i * 4 + 2] += yv[i * 4 + 2] * rsy * g.z; x[i * 4 + 3] += yv[i * 4 + 3] * rsy * g.w;
    }
    if (xdf) {
#pragma unroll
      for (int i = 0; i < 4; ++i) {
        float4 v = {x[i * 4 + 0], x[i * 4 + 1], x[i * 4 + 2], x[i * 4 + 3]};
        *(float4*)(xdf + (size_t)row * DM + i * 256 + lane * 4) = v;
      }
    }
    float rs = 1.f;
    if (outn && go) {
      float s2 = 0.f;
#pragma unroll
      for (int i = 0; i < 16; ++i) s2 += x[i] * x[i];
      s2 = wave_sum(s2);
      rs = rsqrtf(s2 * (1.f / DM) + EPS);
    }
    if (xdb) {
#pragma unroll
      for (int i = 0; i < 4; ++i) {
        uint2 u;
        u.x = pk2(x[i * 4 + 0], x[i * 4 + 1]);
        u.y = pk2(x[i * 4 + 2], x[i * 4 + 3]);
        *(uint2*)(xdb + (size_t)row * DM + i * 256 + lane * 4) = u;
      }
    }
    if (outn) {
#pragma unroll
      for (int i = 0; i < 4; ++i) {
        float4 g = {1.f, 1.f, 1.f, 1.f};
        if (go) g = *(const float4*)(go + i * 256 + lane * 4);
        uint2 u;
        u.x = pk2(x[i * 4 + 0] * rs * g.x, x[i * 4 + 1] * rs * g.y);
        u.y = pk2(x[i * 4 + 2] * rs * g.z, x[i * 4 + 3] * rs * g.w);
        *(uint2*)(outn + (size_t)row * DM + i * 256 + lane * 4) = u;
      }
    }
    cx0 = nx0; cx1 = nx1; cx2 = nx2; cx3 = nx3; cy0 = ny0; cy1 = ny1; cy2 = ny2; cy3 = ny3;
  }
#undef RP_LOAD
}

DI void rowpass_pipe0(int row, int stride, int nrows, const float* __restrict__ xf, u16* __restrict__ xdb, const float* __restrict__ go,
                      u16* __restrict__ outn) {
  const int lane = otid() & 63;
  if (row >= nrows) return;
  float4 c0, c1, c2, c3;
#define RP0_LOAD(r_, a0, a1, a2, a3)                                          \
  do {                                                                        \
    const float* xp_ = xf + (size_t)(r_) * DM + lane * 4;                     \
    a0 = *(const float4*)(xp_); a1 = *(const float4*)(xp_ + 256);            \
    a2 = *(const float4*)(xp_ + 512); a3 = *(const float4*)(xp_ + 768);      \
  } while (0)
  RP0_LOAD(row, c0, c1, c2, c3);
  for (; row < nrows; row += stride) {
    const int rn = row + stride < nrows ? row + stride : row;
    float4 n0, n1, n2, n3;
    RP0_LOAD(rn, n0, n1, n2, n3);
    asm volatile("" ::: "memory");
    __builtin_amdgcn_sched_barrier(0);
    const float x[16] = {c0.x, c0.y, c0.z, c0.w, c1.x, c1.y, c1.z, c1.w, c2.x, c2.y, c2.z, c2.w, c3.x, c3.y, c3.z, c3.w};
    float ss = 0.f;
#pragma unroll
    for (int i = 0; i < 16; ++i) ss += x[i] * x[i];
    ss = wave_sum(ss);
    const float rs = rsqrtf(ss * (1.f / DM) + EPS);
#pragma unroll
    for (int i = 0; i < 4; ++i) {
      uint2 u;
      u.x = pk2(x[i * 4 + 0], x[i * 4 + 1]);
      u.y = pk2(x[i * 4 + 2], x[i * 4 + 3]);
      *(uint2*)(xdb + (size_t)row * DM + i * 256 + lane * 4) = u;
      const float4 g = *(const float4*)(go + i * 256 + lane * 4);
      uint2 w;
      w.x = pk2(x[i * 4 + 0] * rs * g.x, x[i * 4 + 1] * rs * g.y);
      w.y = pk2(x[i * 4 + 2] * rs * g.z, x[i * 4 + 3] * rs * g.w);
      *(uint2*)(outn + (size_t)row * DM + i * 256 + lane * 4) = w;
    }
    c0 = n0; c1 = n1; c2 = n2; c3 = n3;
  }
#undef RP0_LOAD
}

DI void wt_tile(const float* __restrict__ src, int K, int N, u16* __restrict__ dst, const float* __restrict__ gain, int tile, int mode, char* smem) {
  float* t = (float*)smem;
  const int ntn = (N + 63) >> 6;
  const int k0 = (tile / ntn) << 6, n0 = (tile % ntn) << 6;
  const int tid = otid();
  {
    const int kk = tid >> 3, ns = (tid & 7) * 8;
    float g = gain ? gain[k0 + kk] : 1.f;
    if (n0 + ns < N) {
      const float* p = src + (size_t)(k0 + kk) * N + n0 + ns;
      float4 a = *(const float4*)p, b = *(const float4*)(p + 4);
      float* d = t + kk * 65 + ns;
      d[0] = a.x * g; d[1] = a.y * g; d[2] = a.z * g; d[3] = a.w * g; d[4] = b.x * g; d[5] = b.y * g; d[6] = b.z * g; d[7] = b.w * g;
    }
  }
  __syncthreads();
  {
    const int n = tid >> 3, ks = (tid & 7) * 8;
    if (n0 + n < N) {
      uint4 o;
      o.x = pk2(t[(ks + 0) * 65 + n], t[(ks + 1) * 65 + n]);
      o.y = pk2(t[(ks + 2) * 65 + n], t[(ks + 3) * 65 + n]);
      o.z = pk2(t[(ks + 4) * 65 + n], t[(ks + 5) * 65 + n]);
      o.w = pk2(t[(ks + 6) * 65 + n], t[(ks + 7) * 65 + n]);
      int nr = n0 + n;
      if (mode) nr = ((nr >> 7) << 8) + (nr & 127) + (mode == 2 ? 128 : 0);
      *(uint4*)(dst + (size_t)nr * K + k0 + ks) = o;
    }
  }
  __syncthreads();
}

template <int DQK, bool WIN>
DI void attn_item(const u16* __restrict__ qbase, int qld,
                  const u16* __restrict__ kbase, int kld,
                  const u16* __restrict__ vtbase,
                  u16* __restrict__ obase, int old_,
                  const float* __restrict__ rope,
                  const int* __restrict__ posb,
                  int q0, float scale2, float slope2, float sink2, char* smem) {
  constexpr int NS = DQK / 16;
  constexpr int KROW = DQK * 2 + 16;
  constexpr int KCH = DQK / 8;
  constexpr int KBYTES = 64 * KROW;
  constexpr int VROW = 144;
  constexpr int VBYTES = 64 * VROW;
  constexpr int ASTAGE = KBYTES + VBYTES + 256;
  const int tid = otid(), lane = tid & 63, wave = tid >> 6;
  const int lq = lane & 31, h2 = lane >> 5;
  const int wq0 = q0 + wave * 32;
  const int tq = wq0 + lq;
  bf16x8 qf[NS];
  {
    const u16* qp = qbase + (size_t)tq * qld;
    if (!WIN) {
#pragma unroll
      for (int s = 0; s < 4; ++s) qf[s] = *(const bf16x8*)(qp + 16 * s + 8 * h2);
      uint4 u1 = *(const uint4*)(qp + 64 + 8 * h2), u2 = *(const uint4*)(qp + 80 + 8 * h2);
      const float* rp = rope + (size_t)tq * 32 + 8 * h2;
      float4 c0 = *(const float4*)(rp), c1 = *(const float4*)(rp + 4), s0 = *(const float4*)(rp + 16), s1 = *(const float4*)(rp + 20);
      float cs[8] = {c0.x, c0.y, c0.z, c0.w, c1.x, c1.y, c1.z, c1.w};
      float sn[8] = {s0.x, s0.y, s0.z, s0.w, s1.x, s1.y, s1.z, s1.w};
      unsigned a1[4] = {u1.x, u1.y, u1.z, u1.w}, a2[4] = {u2.x, u2.y, u2.z, u2.w};
      unsigned r1[4], r2[4];
#pragma unroll
      for (int j = 0; j < 4; ++j) {
        float x1a = bflo(a1[j]), x1b = bfhi(a1[j]), x2a = bflo(a2[j]), x2b = bfhi(a2[j]);
        r1[j] = pk2(x1a * cs[2 * j] - x2a * sn[2 * j], x1b * cs[2 * j + 1] - x2b * sn[2 * j + 1]);
        r2[j] = pk2(x1a * sn[2 * j] + x2a * cs[2 * j], x1b * sn[2 * j + 1] + x2b * cs[2 * j + 1]);
      }
      uint4 o1 = {r1[0], r1[1], r1[2], r1[3]}, o2 = {r2[0], r2[1], r2[2], r2[3]};
      qf[NS - 2] = __builtin_bit_cast(bf16x8, o1);
      qf[NS - 1] = __builtin_bit_cast(bf16x8, o2);
    } else {
#pragma unroll
      for (int s = 0; s < NS; ++s) qf[s] = *(const bf16x8*)(qp + 16 * s + 8 * h2);
    }
  }
  int posq = 0;
  if (WIN) posq = posb[tq];
  f32x16 o[2];
#pragma unroll
  for (int i = 0; i < 16; ++i) { o[0][i] = 0.f; o[1][i] = 0.f; }
  float mrun = WIN ? sink2 : -INFINITY;
  float lsum = 0.f;
  const int ntiles = WIN ? 8 : (SEQ / 64);
  const int kstart = WIN ? (q0 - 128) : 0;
  uint4 rk0, rk1, rv;
  int rp_ = 0;
  rk0 = rk1 = rv = uint4{0, 0, 0, 0};
  const int c1 = tid + 512;
  auto load_tile = [&](int t) {
    const int k0 = kstart + t * 64;
    const bool valid = !WIN || ((k0 >= 0) && (k0 < SEQ));
    if (valid) {
      rk0 = *(const uint4*)(kbase + (size_t)(k0 + tid / KCH) * kld + (tid % KCH) * 8);
      if (KCH == 12 && c1 < 64 * KCH) rk1 = *(const uint4*)(kbase + (size_t)(k0 + c1 / KCH) * kld + (c1 % KCH) * 8);
      rv = *(const uint4*)(vtbase + (size_t)(tid >> 3) * SEQ + k0 + (tid & 7) * 8);
      if (WIN && tid < 64) rp_ = posb[k0 + tid];
    } else {
      rk0 = rk1 = rv = uint4{0, 0, 0, 0};
      rp_ = 0;
    }
  };
  auto store_tile = [&](int stg) {
    char* sb = smem + stg * ASTAGE;
    *(uint4*)(sb + (tid / KCH) * KROW + (tid % KCH) * 16) = rk0;
    if (KCH == 12 && c1 < 64 * KCH) *(uint4*)(sb + (c1 / KCH) * KROW + (c1 % KCH) * 16) = rk1;
    *(uint4*)(sb + KBYTES + (tid >> 3) * VROW + (tid & 7) * 16) = rv;
    if (WIN && tid < 64) *(int*)(sb + KBYTES + VBYTES + tid * 4) = rp_;
  };
  load_tile(0);
  store_tile(0);
  __syncthreads();
  for (int t = 0; t < ntiles; ++t) {
    load_tile(t + 1 < ntiles ? t + 1 : t);
    __builtin_amdgcn_sched_barrier(0);
    const int k0 = kstart + t * 64;
    bool active = true;
    if (WIN) active = (k0 >= 0) && (k0 < SEQ) && (k0 + 63 >= wq0 - 128) && (k0 <= wq0 + 31 + 128);
    if (active) {
      const char* sb = smem + (t & 1) * ASTAGE;
      f32x16 st[2];
#pragma unroll
      for (int kt2 = 0; kt2 < 2; ++kt2) {
#pragma unroll
        for (int i = 0; i < 16; ++i) st[kt2][i] = 0.f;
#pragma unroll
        for (int s = 0; s < NS; ++s) {
          bf16x8 kf = *(const bf16x8*)(sb + (kt2 * 32 + lq) * KROW + s * 32 + h2 * 16);
          st[kt2] = __builtin_amdgcn_mfma_f32_32x32x16_bf16(kf, qf[s], st[kt2], 0, 0, 0);
        }
      }
      float mx = -INFINITY;
      if (WIN) {
        const float posqf = (float)posq;
        const float tqk = (float)(tq - k0 - 4 * h2);
#pragma unroll
        for (int kt2 = 0; kt2 < 2; ++kt2)
#pragma unroll
          for (int g4 = 0; g4 < 4; ++g4) {
            const int4 pk4i = *(const int4*)(sb + KBYTES + VBYTES + (kt2 * 32 + 8 * g4 + 4 * h2) * 4);
            const float pkf[4] = {(float)pk4i.x, (float)pk4i.y, (float)pk4i.z, (float)pk4i.w};
#pragma unroll
            for (int j = 0; j < 4; ++j) {
              const int r = g4 * 4 + j;
              float v = st[kt2][r] * scale2;
              v = __builtin_fmaf(-slope2, __builtin_fabsf(posqf - pkf[j]), v);
              const float e = tqk - (float)(kt2 * 32 + 8 * g4 + j);
              v = (__builtin_fabsf(e) <= 128.f) ? v : -INFINITY;
              st[kt2][r] = v;
              mx = fmaxf(mx, v);
            }
          }
      } else {
#pragma unroll
        for (int kt2 = 0; kt2 < 2; ++kt2)
#pragma unroll
          for (int r = 0; r < 16; ++r) mx = fmaxf(mx, st[kt2][r]);
        mx *= scale2;
      }
      mx = fmaxf(mx, __shfl_xor(mx, 32, 64));
      if (__builtin_amdgcn_ballot_w64(mx > mrun + 8.f) != 0ull) {
        const float mnew = fmaxf(mrun, mx);
        const float alpha = fexp2(mrun - mnew);
        mrun = mnew;
        lsum *= alpha;
#pragma unroll
        for (int i = 0; i < 16; ++i) { o[0][i] *= alpha; o[1][i] *= alpha; }
      }
      float ps = 0.f;
#pragma unroll
      for (int kt2 = 0; kt2 < 2; ++kt2)
#pragma unroll
        for (int r = 0; r < 16; ++r) {
          const float p = WIN ? fexp2(st[kt2][r] - mrun) : fexp2(__builtin_fmaf(st[kt2][r], scale2, -mrun));
          st[kt2][r] = p;
          ps += p;
        }
      lsum += ps;
#pragma unroll
      for (int kt2 = 0; kt2 < 2; ++kt2)
#pragma unroll
        for (int sp = 0; sp < 2; ++sp) {
          uint4 pu;
          pu.x = pk2(st[kt2][8 * sp + 0], st[kt2][8 * sp + 1]);
          pu.y = pk2(st[kt2][8 * sp + 2], st[kt2][8 * sp + 3]);
          pu.z = pk2(st[kt2][8 * sp + 4], st[kt2][8 * sp + 5]);
          pu.w = pk2(st[kt2][8 * sp + 6], st[kt2][8 * sp + 7]);
          const bf16x8 pf = __builtin_bit_cast(bf16x8, pu);
#pragma unroll
          for (int dt = 0; dt < 2; ++dt) {
            const char* vb = sb + KBYTES + (dt * 32 + lq) * VROW + (kt2 * 32 + 16 * sp + 4 * h2) * 2;
            uint2 lo = *(const uint2*)(vb), hi = *(const uint2*)(vb + 16);
            uint4 vu = {lo.x, lo.y, hi.x, hi.y};
            o[dt] = __builtin_amdgcn_mfma_f32_32x32x16_bf16(__builtin_bit_cast(bf16x8, vu), pf, o[dt], 0, 0, 0);
          }
        }
    }
    __builtin_amdgcn_sched_barrier(0);
    store_tile((t + 1) & 1);
    __syncthreads();
  }
  float ltot = lsum + __shfl_xor(lsum, 32, 64);
  if (WIN) ltot += fexp2(sink2 - mrun);
  const float inv = 1.f / ltot;
  u16* op = obase + (size_t)tq * old_;
#pragma unroll
  for (int dt = 0; dt < 2; ++dt)
#pragma unroll
    for (int g = 0; g < 4; ++g) {
      uint2 u;
      u.x = pk2(o[dt][4 * g + 0] * inv, o[dt][4 * g + 1] * inv);
      u.y = pk2(o[dt][4 * g + 2] * inv, o[dt][4 * g + 3] * inv);
      *(uint2*)(op + dt * 32 + 8 * g + 4 * h2) = u;
    }
}

DI void mla_item(const u16* __restrict__ qbase, const u16* __restrict__ kbase, const u16* __restrict__ vtbase, u16* __restrict__ obase,
                 const float* __restrict__ rope, int q0, float scale2, char* smem) {
  constexpr int NS = 6, KROW = 208, KCH = 12, KBYTES = 64 * KROW, VROW = 144, VBYTES = 64 * VROW, ASTAGE = KBYTES + VBYTES;
  constexpr int NT_ = SEQ / 64;
  const int tid = otid(), lane = tid & 63, wave = tid >> 6;
  const int lq = lane & 31, h2 = lane >> 5;
  const int tq = q0 + wave * 32 + lq;
  bf16x8 qf[NS];
  {
    const u16* qp = qbase + (size_t)tq * 768;
#pragma unroll
    for (int s = 0; s < 4; ++s) qf[s] = *(const bf16x8*)(qp + 16 * s + 8 * h2);
    uint4 u1 = *(const uint4*)(qp + 64 + 8 * h2), u2 = *(const uint4*)(qp + 80 + 8 * h2);
    const float* rp = rope + (size_t)tq * 32 + 8 * h2;
    float4 c0 = *(const float4*)(rp), c1v = *(const float4*)(rp + 4), s0 = *(const float4*)(rp + 16), s1 = *(const float4*)(rp + 20);
    float cs[8] = {c0.x, c0.y, c0.z, c0.w, c1v.x, c1v.y, c1v.z, c1v.w};
    float sn[8] = {s0.x, s0.y, s0.z, s0.w, s1.x, s1.y, s1.z, s1.w};
    unsigned a1[4] = {u1.x, u1.y, u1.z, u1.w}, a2[4] = {u2.x, u2.y, u2.z, u2.w};
    unsigned r1[4], r2[4];
#pragma unroll
    for (int j = 0; j < 4; ++j) {
      float x1a = bflo(a1[j]), x1b = bfhi(a1[j]), x2a = bflo(a2[j]), x2b = bfhi(a2[j]);
      r1[j] = pk2(x1a * cs[2 * j] - x2a * sn[2 * j], x1b * cs[2 * j + 1] - x2b * sn[2 * j + 1]);
      r2[j] = pk2(x1a * sn[2 * j] + x2a * cs[2 * j], x1b * sn[2 * j + 1] + x2b * cs[2 * j + 1]);
    }
    uint4 o1 = {r1[0], r1[1], r1[2], r1[3]}, o2 = {r2[0], r2[1], r2[2], r2[3]};
    qf[4] = __builtin_bit_cast(bf16x8, o1);
    qf[5] = __builtin_bit_cast(bf16x8, o2);
  }
  f32x16 o[2];
#pragma unroll
  for (int i = 0; i < 16; ++i) { o[0][i] = 0.f; o[1][i] = 0.f; }
  float mrun = -INFINITY, lsum = 0.f;
  struct TileRegs { uint4 k0, k1, v; };
  TileRegs ra_, rb_;
  ra_.k0 = ra_.k1 = ra_.v = uint4{0, 0, 0, 0};
  rb_ = ra_;
  const int c1 = tid + 512;
  auto load_tile = [&](int t, TileRegs& r) {
    const int k0 = t * 64;
    r.k0 = *(const uint4*)(kbase + (size_t)(k0 + tid / KCH) * 96 + (tid % KCH) * 8);
    if (c1 < 64 * KCH) r.k1 = *(const uint4*)(kbase + (size_t)(k0 + c1 / KCH) * 96 + (c1 % KCH) * 8);
    r.v = *(const uint4*)(vtbase + (size_t)(tid >> 3) * SEQ + k0 + (tid & 7) * 8);
  };
  auto store_tile = [&](int stg, const TileRegs& r) {
    char* sb = smem + stg * ASTAGE;
    *(uint4*)(sb + (tid / KCH) * KROW + (tid % KCH) * 16) = r.k0;
    if (c1 < 64 * KCH) *(uint4*)(sb + (c1 / KCH) * KROW + (c1 % KCH) * 16) = r.k1;
    const int c = tid & 7;
    char* vp = sb + KBYTES + (tid >> 3) * VROW + (c >> 1) * 32 + (c & 1) * 8;
    *(uint2*)(vp) = uint2{r.v.x, r.v.y};
    *(uint2*)(vp + 16) = uint2{r.v.z, r.v.w};
  };
  auto qk = [&](const char* sb, f32x16 (&st)[2]) {
#pragma unroll
    for (int i = 0; i < 16; ++i) { st[0][i] = 0.f; st[1][i] = 0.f; }
#pragma unroll
    for (int s = 0; s < NS; ++s) {
      const bf16x8 kf0 = *(const bf16x8*)(sb + lq * KROW + s * 32 + h2 * 16);
      const bf16x8 kf1 = *(const bf16x8*)(sb + (32 + lq) * KROW + s * 32 + h2 * 16);
      st[0] = __builtin_amdgcn_mfma_f32_32x32x16_bf16(kf0, qf[s], st[0], 0, 0, 0);
      st[1] = __builtin_amdgcn_mfma_f32_32x32x16_bf16(kf1, qf[s], st[1], 0, 0, 0);
    }
  };
  auto step = [&](int t, f32x16 (&st_c)[2], f32x16 (&st_n)[2]) {
    load_tile(t + 3 < NT_ ? t + 3 : NT_ - 1, rb_);
    __builtin_amdgcn_sched_barrier(0);
    const char* sb = smem + (t % 3) * ASTAGE;
    const char* sbn = smem + ((t + 1) % 3) * ASTAGE;
    float mx = -INFINITY;
#pragma unroll
    for (int kt2 = 0; kt2 < 2; ++kt2)
#pragma unroll
      for (int r = 0; r < 16; ++r) mx = fmaxf(mx, st_c[kt2][r]);
    mx *= scale2;
    mx = fmaxf(mx, __shfl_xor(mx, 32, 64));
    if (__builtin_amdgcn_ballot_w64(mx > mrun + 8.f) != 0ull) {
      asm volatile("" ::: "memory");
      const float mnew = fmaxf(mrun, mx);
      const float alpha = fexp2(mrun - mnew);
      mrun = mnew;
      lsum *= alpha;
#pragma unroll
      for (int i = 0; i < 16; ++i) { o[0][i] *= alpha; o[1][i] *= alpha; }
    }
    qk(sbn, st_n);
    float ps = 0.f;
#pragma unroll
    for (int kt2 = 0; kt2 < 2; ++kt2)
#pragma unroll
      for (int r = 0; r < 16; ++r) {
        const float p = fexp2(__builtin_fmaf(st_c[kt2][r], scale2, -mrun));
        st_c[kt2][r] = p;
        ps += p;
      }
    lsum += ps;
#pragma unroll
    for (int kt2 = 0; kt2 < 2; ++kt2)
#pragma unroll
      for (int sp = 0; sp < 2; ++sp) {
        uint4 pu;
        pu.x = pk2(st_c[kt2][8 * sp + 0], st_c[kt2][8 * sp + 1]);
        pu.y = pk2(st_c[kt2][8 * sp + 2], st_c[kt2][8 * sp + 3]);
        pu.z = pk2(st_c[kt2][8 * sp + 4], st_c[kt2][8 * sp + 5]);
        pu.w = pk2(st_c[kt2][8 * sp + 6], st_c[kt2][8 * sp + 7]);
        const bf16x8 pf = __builtin_bit_cast(bf16x8, pu);
#pragma unroll
        for (int dt = 0; dt < 2; ++dt) {
          const bf16x8 vf = *(const bf16x8*)(sb + KBYTES + (dt * 32 + lq) * VROW + (kt2 * 2 + sp) * 32 + h2 * 16);
          o[dt] = __builtin_amdgcn_mfma_f32_32x32x16_bf16(vf, pf, o[dt], 0, 0, 0);
        }
      }
    __builtin_amdgcn_sched_barrier(0);
    store_tile((t + 2) % 3, ra_);
    __syncthreads();
    ra_ = rb_;
  };
  load_tile(0, ra_);
  load_tile(1, rb_);
  store_tile(0, ra_);
  store_tile(1, rb_);
  load_tile(2, ra_);
  __syncthreads();
  f32x16 sa[2], sb2[2];
  qk(smem, sa);
  for (int t = 0; t < NT_; t += 2) {
    step(t, sa, sb2);
    step(t + 1, sb2, sa);
  }
  const float ltot = lsum + __shfl_xor(lsum, 32, 64);
  const float inv = 1.f / ltot;
  u16* op = obase + (size_t)tq * 512;
#pragma unroll
  for (int dt = 0; dt < 2; ++dt)
#pragma unroll
    for (int g = 0; g < 4; ++g) {
      uint2 u;
      u.x = pk2(o[dt][4 * g + 0] * inv, o[dt][4 * g + 1] * inv);
      u.y = pk2(o[dt][4 * g + 2] * inv, o[dt][4 * g + 3] * inv);
      *(uint2*)(op + dt * 32 + 8 * g + 4 * h2) = u;
    }
}

DI void mla_item_q64(const u16* __restrict__ qbase, const u16* __restrict__ kbase, const u16* __restrict__ vtbase, u16* __restrict__ obase,
                     const float* __restrict__ rope, int q0, float scale2, char* smem) {
  constexpr int NS = 6, KROW = 208, KCH = 12, KBYTES = 64 * KROW, VROW = 144, VBYTES = 64 * VROW, ASTAGE = KBYTES + VBYTES;
  constexpr int NT_ = SEQ / 64;
  const int tid = otid(), lane = tid & 63, wave = tid >> 6;
  const int lq = lane & 31, h2 = lane >> 5;
  const int tqA = q0 + wave * 64 + lq, tqB = tqA + 32;
  auto load_q = [&](int tq, bf16x8 (&qf)[NS]) {
    const u16* qp = qbase + (size_t)tq * 768;
#pragma unroll
    for (int s = 0; s < 4; ++s) {
      const uint4 u = *(const uint4*)(qp + 16 * s + 8 * h2);
      uint4 w;
      w.x = pk2(bflo(u.x) * scale2, bfhi(u.x) * scale2); w.y = pk2(bflo(u.y) * scale2, bfhi(u.y) * scale2);
      w.z = pk2(bflo(u.z) * scale2, bfhi(u.z) * scale2); w.w = pk2(bflo(u.w) * scale2, bfhi(u.w) * scale2);
      qf[s] = __builtin_bit_cast(bf16x8, w);
    }
    uint4 u1 = *(const uint4*)(qp + 64 + 8 * h2), u2 = *(const uint4*)(qp + 80 + 8 * h2);
    const float* rp = rope + (size_t)tq * 32 + 8 * h2;
    float4 c0 = *(const float4*)(rp), c1v = *(const float4*)(rp + 4), s0 = *(const float4*)(rp + 16), s1 = *(const float4*)(rp + 20);
    float cs[8] = {c0.x, c0.y, c0.z, c0.w, c1v.x, c1v.y, c1v.z, c1v.w};
    float sn[8] = {s0.x, s0.y, s0.z, s0.w, s1.x, s1.y, s1.z, s1.w};
    unsigned a1[4] = {u1.x, u1.y, u1.z, u1.w}, a2[4] = {u2.x, u2.y, u2.z, u2.w};
    unsigned r1[4], r2[4];
#pragma unroll
    for (int j = 0; j < 4; ++j) {
      float x1a = bflo(a1[j]), x1b = bfhi(a1[j]), x2a = bflo(a2[j]), x2b = bfhi(a2[j]);
      r1[j] = pk2((x1a * cs[2 * j] - x2a * sn[2 * j]) * scale2, (x1b * cs[2 * j + 1] - x2b * sn[2 * j + 1]) * scale2);
      r2[j] = pk2((x1a * sn[2 * j] + x2a * cs[2 * j]) * scale2, (x1b * sn[2 * j + 1] + x2b * cs[2 * j + 1]) * scale2);
    }
    uint4 o1 = {r1[0], r1[1], r1[2], r1[3]}, o2 = {r2[0], r2[1], r2[2], r2[3]};
    qf[4] = __builtin_bit_cast(bf16x8, o1);
    qf[5] = __builtin_bit_cast(bf16x8, o2);
  };
  bf16x8 qfA[NS], qfB[NS];
  load_q(tqA, qfA);
  load_q(tqB, qfB);
  f32x16 oA[2], oB[2];
#pragma unroll
  for (int i = 0; i < 16; ++i) { oA[0][i] = 0.f; oA[1][i] = 0.f; oB[0][i] = 0.f; oB[1][i] = 0.f; }
  float mA = 0.f, mB = 0.f, lA = 0.f, lB = 0.f;
  const int c1 = tid + 512;
  const bool has1 = c1 < 64 * KCH;
  const u16* kp0 = kbase + (size_t)(tid / KCH) * 96 + (tid % KCH) * 8;
  const u16* kp1 = kbase + (size_t)((has1 ? c1 : tid) / KCH) * 96 + ((has1 ? c1 : tid) % KCH) * 8;
  const u16* vp0 = vtbase + (size_t)(tid >> 3) * SEQ + (tid & 7) * 8;
  const int ks0 = (tid / KCH) * KROW + (tid % KCH) * 16, ks1 = ((has1 ? c1 : tid) / KCH) * KROW + ((has1 ? c1 : tid) % KCH) * 16;
  const int vs0 = KBYTES + (tid >> 3) * VROW + ((tid & 7) >> 1) * 32 + (tid & 1) * 8;
  uint4 rk0, rk1, rv;
#define Q_LOAD(t_)                                              \
  do {                                                          \
    const size_t ko_ = (size_t)(t_) * 64 * 96;                  \
    rk0 = *(const uint4*)(kp0 + ko_);                           \
    rk1 = *(const uint4*)(kp1 + ko_);                           \
    rv = *(const uint4*)(vp0 + (t_) * 64);                      \
  } while (0)
#define Q_STORE(stg_)                                           \
  do {                                                          \
    char* sb_ = smem + (stg_) * ASTAGE;                         \
    *(uint4*)(sb_ + ks0) = rk0;                                 \
    if (has1) *(uint4*)(sb_ + ks1) = rk1;                       \
    *(uint2*)(sb_ + vs0) = uint2{rv.x, rv.y};                   \
    *(uint2*)(sb_ + vs0 + 16) = uint2{rv.z, rv.w};              \
  } while (0)
  auto softmax = [&](f32x16 (&st)[2], float& mrun, float& lsum, f32x16 (&o)[2], bf16x8 (&pf)[2][2], bool first) {
    float mx = -INFINITY;
#pragma unroll
    for (int kt2 = 0; kt2 < 2; ++kt2)
#pragma unroll
      for (int r = 0; r < 16; ++r) mx = fmaxf(mx, st[kt2][r]);
    mx = fmaxf(mx, __shfl_xor(mx, 32, 64));
    if (first || __builtin_amdgcn_ballot_w64(mx > 8.f) != 0ull) {
      asm volatile("" ::: "memory");
      const float delta = first ? mx : fmaxf(mx, 0.f);
      mrun += delta;
      if (!first) {
        const float alpha = fexp2(-delta);
        lsum *= alpha;
#pragma unroll
        for (int i = 0; i < 16; ++i) { o[0][i] *= alpha; o[1][i] *= alpha; }
      }
#pragma unroll
      for (int i = 0; i < 16; ++i) { st[0][i] -= delta; st[1][i] -= delta; }
    }
    float ps = 0.f;
#pragma unroll
    for (int kt2 = 0; kt2 < 2; ++kt2) {
#pragma unroll
      for (int r = 0; r < 16; ++r) {
        const float p = fexp2(st[kt2][r]);
        st[kt2][r] = p;
        ps += p;
      }
#pragma unroll
      for (int sp = 0; sp < 2; ++sp) {
        uint4 pu;
        pu.x = pk2(st[kt2][8 * sp + 0], st[kt2][8 * sp + 1]);
        pu.y = pk2(st[kt2][8 * sp + 2], st[kt2][8 * sp + 3]);
        pu.z = pk2(st[kt2][8 * sp + 4], st[kt2][8 * sp + 5]);
        pu.w = pk2(st[kt2][8 * sp + 6], st[kt2][8 * sp + 7]);
        pf[kt2][sp] = __builtin_bit_cast(bf16x8, pu);
      }
    }
    lsum += ps;
  };
  Q_LOAD(0);
  Q_STORE(0);
  __syncthreads();
  for (int t = 0; t < NT_; ++t) {
    { const int tn = t + 1 < NT_ ? t + 1 : t; Q_LOAD(tn); }
    __builtin_amdgcn_sched_barrier(0);
    const char* sb = smem + (t & 1) * ASTAGE;
    bf16x8 pA[2][2], pB[2][2];
    {
      f32x16 stA[2], stB[2];
      {
        f32x16 nA, nB;
#pragma unroll
        for (int i = 0; i < 16; ++i) { nA[i] = -mA; nB[i] = -mB; }
        const bf16x8 kf0 = *(const bf16x8*)(sb + lq * KROW + h2 * 16);
        const bf16x8 kf1 = *(const bf16x8*)(sb + (32 + lq) * KROW + h2 * 16);
        stA[0] = __builtin_amdgcn_mfma_f32_32x32x16_bf16(kf0, qfA[0], nA, 0, 0, 0);
        stB[0] = __builtin_amdgcn_mfma_f32_32x32x16_bf16(kf0, qfB[0], nB, 0, 0, 0);
        stA[1] = __builtin_amdgcn_mfma_f32_32x32x16_bf16(kf1, qfA[0], nA, 0, 0, 0);
        stB[1] = __builtin_amdgcn_mfma_f32_32x32x16_bf16(kf1, qfB[0], nB, 0, 0, 0);
      }
#pragma unroll
      for (int s = 1; s < NS; ++s) {
        const bf16x8 kf0 = *(const bf16x8*)(sb + lq * KROW + s * 32 + h2 * 16);
        const bf16x8 kf1 = *(const bf16x8*)(sb + (32 + lq) * KROW + s * 32 + h2 * 16);
        stA[0] = __builtin_amdgcn_mfma_f32_32x32x16_bf16(kf0, qfA[s], stA[0], 0, 0, 0);
        stB[0] = __builtin_amdgcn_mfma_f32_32x32x16_bf16(kf0, qfB[s], stB[0], 0, 0, 0);
        stA[1] = __builtin_amdgcn_mfma_f32_32x32x16_bf16(kf1, qfA[s], stA[1], 0, 0, 0);
        stB[1] = __builtin_amdgcn_mfma_f32_32x32x16_bf16(kf1, qfB[s], stB[1], 0, 0, 0);
      }
      softmax(stA, mA, lA, oA, pA, t == 0);
      softmax(stB, mB, lB, oB, pB, t == 0);
    }
#pragma unroll
    for (int kt2 = 0; kt2 < 2; ++kt2)
#pragma unroll
      for (int sp = 0; sp < 2; ++sp)
#pragma unroll
        for (int dt = 0; dt < 2; ++dt) {
          const bf16x8 vf = *(const bf16x8*)(sb + KBYTES + (dt * 32 + lq) * VROW + (kt2 * 2 + sp) * 32 + h2 * 16);
          oA[dt] = __builtin_amdgcn_mfma_f32_32x32x16_bf16(vf, pA[kt2][sp], oA[dt], 0, 0, 0);
          oB[dt] = __builtin_amdgcn_mfma_f32_32x32x16_bf16(vf, pB[kt2][sp], oB[dt], 0, 0, 0);
        }
    __builtin_amdgcn_sched_barrier(0);
    Q_STORE((t + 1) & 1);
    __syncthreads();
  }
#undef Q_LOAD
#undef Q_STORE
  {
    const float inv = 1.f / (lA + __shfl_xor(lA, 32, 64));
    u16* op = obase + (size_t)tqA * 512;
#pragma unroll
    for (int dt = 0; dt < 2; ++dt)
#pragma unroll
      for (int g = 0; g < 4; ++g) {
        uint2 u;
        u.x = pk2(oA[dt][4 * g + 0] * inv, oA[dt][4 * g + 1] * inv);
        u.y = pk2(oA[dt][4 * g + 2] * inv, oA[dt][4 * g + 3] * inv);
        *(uint2*)(op + dt * 32 + 8 * g + 4 * h2) = u;
      }
  }
  {
    const float inv = 1.f / (lB + __shfl_xor(lB, 32, 64));
    u16* op = obase + (size_t)tqB * 512;
#pragma unroll
    for (int dt = 0; dt < 2; ++dt)
#pragma unroll
      for (int g = 0; g < 4; ++g) {
        uint2 u;
        u.x = pk2(oB[dt][4 * g + 0] * inv, oB[dt][4 * g + 1] * inv);
        u.y = pk2(oB[dt][4 * g + 2] * inv, oB[dt][4 * g + 3] * inv);
        *(uint2*)(op + dt * 32 + 8 * g + 4 * h2) = u;
      }
  }
}

DI void gqa_item_pair(const u16* __restrict__ qbA, const u16* __restrict__ kbase, const u16* __restrict__ vtbase, u16* __restrict__ obA,
                      const int* __restrict__ posb, int q0, float scale2, float slopeA, float slopeB, float sinkA, float sinkB, char* smem) {
  constexpr int NS = 4, KROW = 144, KBYTES = 64 * KROW, VROW = 144, VBYTES = 64 * VROW, ASTAGE = KBYTES + VBYTES + 256;
  const int tid = otid(), lane = tid & 63, wave = tid >> 6;
  const int lq = lane & 31, h2 = lane >> 5;
  const int wq0 = q0 + wave * 32;
  const int tq = wq0 + lq;
  bf16x8 qfA[NS], qfB[NS];
  {
    const u16* qp = qbA + (size_t)tq * ZS;
#pragma unroll
    for (int s = 0; s < NS; ++s) { qfA[s] = *(const bf16x8*)(qp + 16 * s + 8 * h2); qfB[s] = *(const bf16x8*)(qp + 64 + 16 * s + 8 * h2); }
  }
  const float posqf = (float)posb[tq];
  f32x16 oA[2], oB[2];
#pragma unroll
  for (int i = 0; i < 16; ++i) { oA[0][i] = 0.f; oA[1][i] = 0.f; oB[0][i] = 0.f; oB[1][i] = 0.f; }
  float mA = sinkA, mB = sinkB, lA = 0.f, lB = 0.f;
  const int kstart = q0 - 128;
  uint4 rk, rv;
  int rp_ = 0;
  auto load_tile = [&](int t) {
    const int k0 = kstart + t * 64;
    if ((k0 >= 0) && (k0 < SEQ)) {
      rk = *(const uint4*)(kbase + (size_t)(k0 + (tid >> 3)) * ZS + (tid & 7) * 8);
      rv = *(const uint4*)(vtbase + (size_t)(tid >> 3) * SEQ + k0 + (tid & 7) * 8);
      if (tid < 64) rp_ = posb[k0 + tid];
    } else {
      rk = rv = uint4{0, 0, 0, 0};
      rp_ = 0;
    }
  };
  auto store_tile = [&](int stg) {
    char* sb = smem + stg * ASTAGE;
    *(uint4*)(sb + (tid >> 3) * KROW + (tid & 7) * 16) = rk;
    const int c = tid & 7;
    char* vp = sb + KBYTES + (tid >> 3) * VROW + (c >> 1) * 32 + (c & 1) * 8;
    *(uint2*)(vp) = uint2{rv.x, rv.y};
    *(uint2*)(vp + 16) = uint2{rv.z, rv.w};
    if (tid < 64) *(int*)(sb + KBYTES + VBYTES + tid * 4) = rp_;
  };
  auto softmax = [&](f32x16 (&st)[2], float& mrun, float& lsum, f32x16 (&o)[2], bf16x8 (&pf)[2][2]) {
    float mx = -INFINITY;
#pragma unroll
    for (int kt2 = 0; kt2 < 2; ++kt2)
#pragma unroll
      for (int r = 0; r < 16; ++r) mx = fmaxf(mx, st[kt2][r]);
    mx = fmaxf(mx, __shfl_xor(mx, 32, 64));
    if (__builtin_amdgcn_ballot_w64(mx > mrun + 8.f) != 0ull) {
      asm volatile("" ::: "memory");
      const float mnew = fmaxf(mrun, mx);
      const float alpha = fexp2(mrun - mnew);
      mrun = mnew;
      lsum *= alpha;
#pragma unroll
      for (int i = 0; i < 16; ++i) { o[0][i] *= alpha; o[1][i] *= alpha; }
    }
    float ps = 0.f;
#pragma unroll
    for (int kt2 = 0; kt2 < 2; ++kt2) {
#pragma unroll
      for (int r = 0; r < 16; ++r) {
        const float p = fexp2(st[kt2][r] - mrun);
        st[kt2][r] = p;
        ps += p;
      }
#pragma unroll
      for (int sp = 0; sp < 2; ++sp) {
        uint4 pu;
        pu.x = pk2(st[kt2][8 * sp + 0], st[kt2][8 * sp + 1]);
        pu.y = pk2(st[kt2][8 * sp + 2], st[kt2][8 * sp + 3]);
        pu.z = pk2(st[kt2][8 * sp + 4], st[kt2][8 * sp + 5]);
        pu.w = pk2(st[kt2][8 * sp + 6], st[kt2][8 * sp + 7]);
        pf[kt2][sp] = __builtin_bit_cast(bf16x8, pu);
      }
    }
    lsum += ps;
  };
  load_tile(0);
  store_tile(0);
  __syncthreads();
  for (int t = 0; t < 8; ++t) {
    load_tile(t + 1 < 8 ? t + 1 : t);
    __builtin_amdgcn_sched_barrier(0);
    const int k0 = kstart + t * 64;
    const bool active = (k0 >= 0) && (k0 < SEQ) && (k0 + 63 >= wq0 - 128) && (k0 <= wq0 + 31 + 128);
    if (active) {
      const char* sb = smem + (t & 1) * ASTAGE;
      bf16x8 pA[2][2], pB[2][2];
      {
        f32x16 stA[2], stB[2];
#pragma unroll
        for (int i = 0; i < 16; ++i) { stA[0][i] = 0.f; stA[1][i] = 0.f; stB[0][i] = 0.f; stB[1][i] = 0.f; }
#pragma unroll
        for (int s = 0; s < NS; ++s) {
          const bf16x8 kf0 = *(const bf16x8*)(sb + lq * KROW + s * 32 + h2 * 16);
          const bf16x8 kf1 = *(const bf16x8*)(sb + (32 + lq) * KROW + s * 32 + h2 * 16);
          stA[0] = __builtin_amdgcn_mfma_f32_32x32x16_bf16(kf0, qfA[s], stA[0], 0, 0, 0);
          stB[0] = __builtin_amdgcn_mfma_f32_32x32x16_bf16(kf0, qfB[s], stB[0], 0, 0, 0);
          stA[1] = __builtin_amdgcn_mfma_f32_32x32x16_bf16(kf1, qfA[s], stA[1], 0, 0, 0);
          stB[1] = __builtin_amdgcn_mfma_f32_32x32x16_bf16(kf1, qfB[s], stB[1], 0, 0, 0);
        }
        const float tqk = (float)(tq - k0 - 4 * h2);
#pragma unroll
        for (int kt2 = 0; kt2 < 2; ++kt2)
#pragma unroll
          for (int g4 = 0; g4 < 4; ++g4) {
            const int4 pk4i = *(const int4*)(sb + KBYTES + VBYTES + (kt2 * 32 + 8 * g4 + 4 * h2) * 4);
            const float pkf[4] = {(float)pk4i.x, (float)pk4i.y, (float)pk4i.z, (float)pk4i.w};
#pragma unroll
            for (int j = 0; j < 4; ++j) {
              const int r = g4 * 4 + j;
              const float dist = __builtin_fabsf(posqf - pkf[j]);
              const bool inb = __builtin_fabsf(tqk - (float)(kt2 * 32 + 8 * g4 + j)) <= 128.f;
              const float va = __builtin_fmaf(-slopeA, dist, stA[kt2][r] * scale2);
              const float vb = __builtin_fmaf(-slopeB, dist, stB[kt2][r] * scale2);
              stA[kt2][r] = inb ? va : -INFINITY;
              stB[kt2][r] = inb ? vb : -INFINITY;
            }
          }
        softmax(stA, mA, lA, oA, pA);
        softmax(stB, mB, lB, oB, pB);
      }
#pragma unroll
      for (int kt2 = 0; kt2 < 2; ++kt2)
#pragma unroll
        for (int sp = 0; sp < 2; ++sp)
#pragma unroll
          for (int dt = 0; dt < 2; ++dt) {
            const bf16x8 vf = *(const bf16x8*)(sb + KBYTES + (dt * 32 + lq) * VROW + (kt2 * 2 + sp) * 32 + h2 * 16);
            oA[dt] = __builtin_amdgcn_mfma_f32_32x32x16_bf16(vf, pA[kt2][sp], oA[dt], 0, 0, 0);
            oB[dt] = __builtin_amdgcn_mfma_f32_32x32x16_bf16(vf, pB[kt2][sp], oB[dt], 0, 0, 0);
          }
    }
    __builtin_amdgcn_sched_barrier(0);
    store_tile((t + 1) & 1);
    __syncthreads();
  }
  {
    const float inv = 1.f / (lA + __shfl_xor(lA, 32, 64) + fexp2(sinkA - mA));
    u16* op = obA + (size_t)tq * 512;
#pragma unroll
    for (int dt = 0; dt < 2; ++dt)
#pragma unroll
      for (int g = 0; g < 4; ++g) {
        uint2 u;
        u.x = pk2(oA[dt][4 * g + 0] * inv, oA[dt][4 * g + 1] * inv);
        u.y = pk2(oA[dt][4 * g + 2] * inv, oA[dt][4 * g + 3] * inv);
        *(uint2*)(op + dt * 32 + 8 * g + 4 * h2) = u;
      }
  }
  {
    const float inv = 1.f / (lB + __shfl_xor(lB, 32, 64) + fexp2(sinkB - mB));
    u16* op = obA + (size_t)tq * 512 + 64;
#pragma unroll
    for (int dt = 0; dt < 2; ++dt)
#pragma unroll
      for (int g = 0; g < 4; ++g) {
        uint2 u;
        u.x = pk2(oB[dt][4 * g + 0] * inv, oB[dt][4 * g + 1] * inv);
        u.y = pk2(oB[dt][4 * g + 2] * inv, oB[dt][4 * g + 3] * inv);
        *(uint2*)(op + dt * 32 + 8 * g + 4 * h2) = u;
      }
  }
}

#define XB_XCNT(j) (64 * (j))
#define XB_XSUB(j) (1024 + 64 * (j))
#define XB_XGEN(j) (2048 + 64 * (j))
#define XB_TOP 3072
#define XB_TOPGEN 3136
#define XB_WORDS 3200
DI unsigned xb_ld(unsigned* p) { return __hip_atomic_load(p, __ATOMIC_RELAXED, __HIP_MEMORY_SCOPE_AGENT); }
DI unsigned xb_add(unsigned* p, unsigned v) { return __hip_atomic_fetch_add(p, v, __ATOMIC_RELAXED, __HIP_MEMORY_SCOPE_AGENT); }
struct GBar { unsigned* bar; const int* ctl; };
#define XB_SPIN(cond) do { unsigned sp_ = 0; while (cond) { __builtin_amdgcn_s_sleep(1); if (++sp_ > (1u << 22)) break; } } while (0)
DI void gbar_sync(const GBar& b) {
  asm volatile("s_waitcnt vmcnt(0)" ::: "memory");
  __syncthreads();
  if (threadIdx.x == 0) {
    unsigned* bar = b.bar;
    __builtin_amdgcn_s_waitcnt(0);
    const unsigned bx = (unsigned)b.ctl[1], nloc = (unsigned)b.ctl[2], nx = (unsigned)b.ctl[3];
    const unsigned old = xb_add(&bar[XB_XSUB(bx)], 1u);
    const unsigned gen = old / nloc;
    if (old + 1u == (gen + 1u) * nloc) {
      __builtin_amdgcn_fence(__ATOMIC_RELEASE, "agent");
      asm volatile("s_waitcnt vmcnt(0)" ::: "memory");
      const unsigned og = xb_add(&bar[XB_TOP], 1u);
      const unsigned tg = og / nx;
      if (og + 1u == (tg + 1u) * nx) xb_add(&bar[XB_TOPGEN], 1u);
      else XB_SPIN(xb_ld(&bar[XB_TOPGEN]) == tg);
      __builtin_amdgcn_fence(__ATOMIC_ACQUIRE, "agent");
      xb_add(&bar[XB_XGEN(bx)], 1u);
      asm volatile("s_waitcnt vmcnt(0)" ::: "memory");
    } else {
      XB_SPIN(xb_ld(&bar[XB_XGEN(bx)]) == gen);
      __builtin_amdgcn_fence(__ATOMIC_ACQUIRE, "agent");
      asm volatile("s_waitcnt vmcnt(0)" ::: "memory");
    }
  }
  __syncthreads();
}

__global__ void __launch_bounds__(NTHR) mega(Params p) {
  extern __shared__ __attribute__((aligned(16))) char smem[];
  const int bid = blockIdx.x, nblk = gridDim.x;
  unsigned char* ws = p.ws;
  u16* Wall = (u16*)(ws + OFF_W);
  u16* E1 = (u16*)(ws + OFF_E1);
  u16* E2 = (u16*)(ws + OFF_E2);
  u16* E3 = (u16*)(ws + OFF_E3);
  float* ropetab = (float*)(ws + OFF_ROPE);
  u16* pb = (u16*)(ws + OFF_PB);
  u16* hbuf = (u16*)(ws + OFF_H);
  u16* oa = (u16*)(ws + OFF_OA);
  u16* oc = (u16*)(ws + OFF_OC);
  u16* zs = (u16*)(ws + R_ZS);
  u16* qm = (u16*)(ws + R_QM);
  u16* kfull = (u16*)(ws + R_KF);
  u16* vt = (u16*)(ws + R_VT);
  u16* vtc = (u16*)(ws + R_VTC);
  u16* yt = (u16*)(ws + R_YT);
  u16* tp = (u16*)(ws + R_TP);
  u16* ob = (u16*)(ws + R_OB);
  u16* merged = (u16*)(ws + OFF_H);
  u16* gbuf = (u16*)(ws + R_GATE);
  u16* ybuf = (u16*)(ws + R_Y);
  u16* hid = (u16*)(ws + R_HID);
  u16* ff = (u16*)(ws + R_FF);
  u16* ebuf = (u16*)(ws + R_E);
  float* xout = p.out;
  u16* x16 = (u16*)((char*)p.out + 64 * MiB);
  float* aux = (float*)(smem + LDS_AUX);

  int rank;
  GBar gb;
  {
    unsigned* bar = (unsigned*)(ws + OFF_CNT);
    int* auxi = (int*)(smem + LDS_CTL);
    const int t0 = otid();
    unsigned xcc = 0, slot = 0;
    if (t0 == 0) {
      xcc = (unsigned)__builtin_amdgcn_s_getreg((3 << 11) | 20) & 0xFu;
      slot = xb_add(&bar[XB_XCNT(xcc)], 1u);
    }
    if (p.ph_hi < 0) cg::this_grid().sync();
    if (t0 == 0) {
      unsigned r = slot, nloc = 1, nx = 0, spins = 0;
      for (;;) {
        unsigned sum = 0;
        r = slot; nloc = 1; nx = 0;
        for (unsigned x = 0; x < 16; ++x) {
          const unsigned c = xb_ld(&bar[XB_XCNT(x)]);
          sum += c;
          if (x < xcc) r += c;
          if (x == xcc) nloc = c;
          nx += (c > 0u) ? 1u : 0u;
        }
        if (sum == (unsigned)nblk || ++spins > (1u << 20)) break;
        __builtin_amdgcn_s_sleep(1);
      }
      auxi[0] = (int)r; auxi[1] = (int)xcc; auxi[2] = (int)(nloc ? nloc : 1u); auxi[3] = (int)(nx ? nx : 1u);
    }
    __syncthreads();
    rank = __builtin_amdgcn_readfirstlane(auxi[0]);
    gb.bar = bar;
    gb.ctl = auxi;
  }
  for (int ph = p.ph_lo; ph < p.ph_hi; ++ph) {
    if (ph > p.ph_lo) gbar_sync(gb);
    if (ph == 0) {
      const int tid = otid(), wave = tid >> 6;
      for (int it0 = bid; it0 < 2 * WT_ITEMS_LAYER; it0 += nblk) {
        const int layer = it0 / WT_ITEMS_LAYER;
        int it = it0 % WT_ITEMS_LAYER;
        const float* src = nullptr; const float* gain = nullptr; int K = 0, N = 0, mode = 0; size_t doff = 0; bool found = false;
#define WSEL(cnt, IDX, KK, NN, DOFF, G, MODE)                                                             \
  if (!found) {                                                                                           \
    if (it < (cnt)) { src = p.in[IDX] + (size_t)layer * (KK) * (NN); K = (KK); N = (NN); doff = (DOFF); gain = (G); mode = (MODE); found = true; } \
    else it -= (cnt);                                                                                     \
  }
        WSEL(1104, 4, 1024, INC, W_IN, nullptr, 0)
        WSEL(72, 6, 384, 768, W_UQ, p.in[5] + layer * 384, 0)
        WSEL(32, 8, 128, 1024, W_UKV, p.in[7] + layer * 128, 0)
        WSEL(128, 10, 512, 1024, W_A, nullptr, 0)
        WSEL(256, 11, 1024, 1024, W_B, nullptr, 0)
        WSEL(128, 12, 512, 1024, W_C, nullptr, 0)
        WSEL(256, 13, 1024, 1024, W_OUT, nullptr, 0)
        WSEL(704, 16, 1024, FFN, W_FG, nullptr, 1)
        WSEL(704, 17, 1024, FFN, W_FG, nullptr, 2)
        WSEL(704, 18, FFN, 1024, W_FD, nullptr, 0)
        WSEL(64, 20, 256, 1024, W_PLE, nullptr, 0)
        WSEL(256, 21, 1024, 1024, W_PG, nullptr, 0)
#undef WSEL
        wt_tile(src, K, N, Wall + (size_t)layer * W_LAYER + doff, gain, it, mode, smem);
      }
      for (int it = bid; it < NTOK * 16 / NTHR; it += nblk) {
        const int e = it * NTHR + tid;
        const int tok = e >> 4, i = e & 15;
        const float invf = powf(10000.f, -(float)i / 16.f);
        const float ang = (float)p.pos[tok] * invf;
        double r = (double)ang * 0.15915494309189535;
        r -= floor(r);
        const float rf = (float)r;
        ropetab[(size_t)tok * 32 + i] = cos_rev(rf);
        ropetab[(size_t)tok * 32 + 16 + i] = sin_rev(rf);
      }
      for (int it = bid; it < (131072 + 65536 + 1048576) / NTHR; it += nblk) {
        int e = it * NTHR + tid;
        if (e < 131072) {
          const int n = e >> 8, c = e & 255, comp = n >> 8, cp = n & 255;
          const float r = (float)((c * cp) & 255) * (1.f / 256.f);
          E1[e] = f2bf((comp ? -sin_rev(r) : cos_rev(r)) * (1.f / 16.f));
        } else if (e < 131072 + 65536) {
          e -= 131072;
          const int n = e >> 8, k = e & 255, comp = n >> 7, k1 = n & 127, part = k >> 7, n1 = k & 127;
          const float r = (float)((k1 * n1) & 127) * (1.f / 128.f);
          const float cc = cos_rev(r), ss = sin_rev(r);
          float v = comp == 0 ? (part == 0 ? cc : ss) : (part == 0 ? -ss : cc);
          E2[e] = f2bf(v * 0.08838834764831845f);
        } else {
          e -= 131072 + 65536;
          const int k1 = e >> 13, row = (e >> 7) & 63, k = e & 127, part = k >> 6, n2 = k & 63;
          const int kk = k1 + 128 * row;
          const float r = (float)((n2 * kk) & 8191) * (1.f / 8192.f);
          E3[e] = f2bf((part == 0 ? cos_rev(r) : sin_rev(r)) * 0.125f);
        }
      }
      {
        constexpr int PN = 2 * NTOK * PLE / (NTHR * 8);
        const float* pin = p.in[1];
        for (int it = bid; it < PN; it += 4 * nblk) {
          const int i1 = it + nblk, i2 = it + 2 * nblk, i3 = it + 3 * nblk;
          const size_t e0 = ((size_t)it * NTHR + tid) * 8;
          const size_t e1 = ((size_t)(i1 < PN ? i1 : it) * NTHR + tid) * 8;
          const size_t e2 = ((size_t)(i2 < PN ? i2 : it) * NTHR + tid) * 8;
          const size_t e3 = ((size_t)(i3 < PN ? i3 : it) * NTHR + tid) * 8;
          const float4 a0 = *(const float4*)(pin + e0), b0 = *(const float4*)(pin + e0 + 4);
          const float4 a1 = *(const float4*)(pin + e1), b1 = *(const float4*)(pin + e1 + 4);
          const float4 a2 = *(const float4*)(pin + e2), b2 = *(const float4*)(pin + e2 + 4);
          const float4 a3 = *(const float4*)(pin + e3), b3 = *(const float4*)(pin + e3 + 4);
          asm volatile("" ::: "memory");
          *(uint4*)(pb + e0) = uint4{pk2(a0.x, a0.y), pk2(a0.z, a0.w), pk2(b0.x, b0.y), pk2(b0.z, b0.w)};
          *(uint4*)(pb + e1) = uint4{pk2(a1.x, a1.y), pk2(a1.z, a1.w), pk2(b1.x, b1.y), pk2(b1.z, b1.w)};
          *(uint4*)(pb + e2) = uint4{pk2(a2.x, a2.y), pk2(a2.z, a2.w), pk2(b2.x, b2.y), pk2(b2.z, b2.w)};
          *(uint4*)(pb + e3) = uint4{pk2(a3.x, a3.y), pk2(a3.z, a3.w), pk2(b3.x, b3.y), pk2(b3.z, b3.w)};
        }
      }
      rowpass_pipe0(bid * 8 + wave, nblk * 8, NTOK, p.in[0], x16, p.in[3], hbuf);
      continue;
    }
    const int layer = (ph - 1) / 15;
    const int sub = (ph - 1) % 15;
    const u16* W = Wall + (size_t)layer * W_LAYER;
    if (sub == 0) {
      {
        pg8::Order<8> S{6, 128 * 6, nblk, rank};
        pg8::gemm_phase((PG8_LAS unsigned char*)smem, pg8::Gemm{hbuf, W + W_IN, DM, 1024, 1024}, S, pg8::EpiZs{zs, vtc});
      }
    } else if (sub == 1) {
      for (int v = rank; v < 128 * 6 + 128 * 8 + 512; v += nblk) {
        const int it = v;
        const int tid = otid();
        if (it < 128 * 14) {
          const bool isq = it < 128 * 6;
          const int t2 = isq ? it : it - 128 * 6;
          const int nn = isq ? 6 : 8;
          int pm, pn; tile_of<4>(t2, nn, pm, pn);
          const int m0 = pm * 256, n0 = pn * 128;
          const int coff = isq ? 0 : 384, kd = isq ? 384 : 128;
          {
            const int row = tid >> 1, half = tid & 1;
            const u16* rp = zs + (size_t)(m0 + row) * ZS + coff + half * (kd >> 1);
            float ss = 0.f;
            for (int c = 0; c < (kd >> 4); ++c) {
              uint4 u = *(const uint4*)(rp + c * 8);
              float a;
              a = bflo(u.x); ss += a * a; a = bfhi(u.x); ss += a * a; a = bflo(u.y); ss += a * a; a = bfhi(u.y); ss += a * a;
              a = bflo(u.z); ss += a * a; a = bfhi(u.z); ss += a * a; a = bflo(u.w); ss += a * a; a = bfhi(u.w); ss += a * a;
            }
            ss += __shfl_xor(ss, 1, 64);
            if (half == 0) aux[row] = rsqrtf(ss / (float)kd + EPS);
          }
          __syncthreads();
          f32x4 acc[4][4];
          zero_acc<4, 4>(acc);
          if (isq) {
            gemm_main<4, 4, true>(acc, RowLin{zs, ZS}, m0, W + W_UQ, 384, n0, 384, smem);
            gemm_epi<4, 4, true>(acc, m0, n0, [&](int m, int n, f32x4 v, int, int) {
              const float rs = aux[m - m0];
              *(uint2*)(qm + (size_t)m * 768 + n) = pk4(v * rs);
            });
          } else {
            gemm_main<4, 4, true>(acc, RowLin{zs + 384, ZS}, m0, W + W_UKV, 128, n0, 128, smem);
            gemm_epi<4, 4, true>(acc, m0, n0, [&](int m, int n, f32x4 v, int, int) {
              const float rs = aux[m - m0];
              const int hd = n >> 7, w = n & 127, b = m >> 13, s = m & 8191;
              if (w < 64) {
                *(uint2*)(kfull + ((size_t)(b * 8 + hd) * SEQ + s) * 96 + w) = pk4(v * rs);
              } else {
                u16* q = vt + ((size_t)(b * 8 + hd) * 64 + (w - 64)) * SEQ + s;
                q[0] = f2bf(v[0] * rs); q[SEQ] = f2bf(v[1] * rs); q[2 * SEQ] = f2bf(v[2] * rs); q[3 * SEQ] = f2bf(v[3] * rs);
              }
            });
          }
          __syncthreads();
        } else {
          const int e = (it - 128 * 14) * NTHR + tid;
          const int tok = e >> 3, hd = e & 7, b = tok >> 13, s = tok & 8191;
          const u16* kr = zs + (size_t)tok * ZS + 512;
          const float* rp = ropetab + (size_t)tok * 32;
          u16* dst = kfull + ((size_t)(b * 8 + hd) * SEQ + s) * 96 + 64;
          unsigned o1[8], o2[8];
#pragma unroll
          for (int c = 0; c < 2; ++c) {
            uint4 u1 = *(const uint4*)(kr + c * 8), u2 = *(const uint4*)(kr + 16 + c * 8);
            unsigned a1[4] = {u1.x, u1.y, u1.z, u1.w}, a2[4] = {u2.x, u2.y, u2.z, u2.w};
#pragma unroll
            for (int j = 0; j < 4; ++j) {
              const int i0 = c * 8 + 2 * j;
              const float c0 = rp[i0], c1 = rp[i0 + 1], s0 = rp[16 + i0], s1 = rp[16 + i0 + 1];
              const float x1a = bflo(a1[j]), x1b = bfhi(a1[j]), x2a = bflo(a2[j]), x2b = bfhi(a2[j]);
              o1[c * 4 + j] = pk2(x1a * c0 - x2a * s0, x1b * c1 - x2b * s1);
              o2[c * 4 + j] = pk2(x1a * s0 + x2a * c0, x1b * s1 + x2b * c1);
            }
          }
          *(uint4*)(dst) = uint4{o1[0], o1[1], o1[2], o1[3]};
          *(uint4*)(dst + 8) = uint4{o1[4], o1[5], o1[6], o1[7]};
          *(uint4*)(dst + 16) = uint4{o2[0], o2[1], o2[2], o2[3]};
          *(uint4*)(dst + 24) = uint4{o2[4], o2[5], o2[6], o2[7]};
        }
      }
    } else if (sub == 2) {
      for (int v = rank; v < 512 + 512; v += nblk) {
        const int it = v;
        if (it < 512) {
          const int bh = it >> 4, qb = it & 15, b = bh >> 3, hd = bh & 7;
          mla_item_q64(qm + (size_t)b * SEQ * 768 + hd * 96, kfull + (size_t)bh * SEQ * 96, vt + (size_t)bh * 64 * SEQ,
                       oa + (size_t)b * SEQ * 512 + hd * 64, ropetab + (size_t)b * SEQ * 32, qb * 512, 0.10206207261596577f * LOG2E, smem);
        } else {
          const int i2 = it - 512;
          const int bp = i2 >> 5, qb = i2 & 31, b = bp >> 2, kvh = (bp >> 1) & 1, hq = kvh * 4 + (bp & 1) * 2;
          const float slA = exp2f(-(float)(hq + 1)) * LOG2E, slB = exp2f(-(float)(hq + 2)) * LOG2E;
          const float skA = p.in[9][layer * 8 + hq] * LOG2E, skB = p.in[9][layer * 8 + hq + 1] * LOG2E;
          gqa_item_pair(zs + (size_t)b * SEQ * ZS + 544 + hq * 64, zs + (size_t)b * SEQ * ZS + 1056 + kvh * 64,
                        vtc + (size_t)(b * 2 + kvh) * 64 * SEQ, oc + (size_t)b * SEQ * 512 + hq * 64, p.pos + b * SEQ, qb * 256,
                        0.125f * LOG2E, slA, slB, skA, skB, smem);
        }
      }
    } else if (sub == 3) {
      for (int it = bid; it < 4 * 4 * 32 * 4; it += nblk) {
        const int nt = it & 3, n2p = (it >> 2) & 31, g = (it >> 7) & 3, b = it >> 9;
        const u16* hb = hbuf + (size_t)b * SEQ * DM + g * 256;
        auto arow = [&](int m) { const int n2 = n2p * 2 + (m >> 7), n1 = m & 127; return hb + (size_t)(64 * n1 + n2) * DM; };
        f32x4 acc[4][4];
        zero_acc<4, 4>(acc);
        gemm_main<4, 4, false>(acc, arow, 0, E1, 256, nt * 128, 256, smem);
        gemm_epi<4, 4, false>(acc, 0, nt * 128, [&](int m, int n, f32x4 v, int, int) {
          const int n2 = n2p * 2 + (m >> 7), n1 = m & 127, comp = n >> 8, cp = n & 255;
          *(uint2*)(yt + ((((size_t)(b * 4 + g) * 256 + cp) * 64 + n2) * 2 + comp) * 128 + n1) = pk4(v);
        });
      }
    } else if (sub == 4) {
      {
        pg8::Order<1> S{1024, 1024, nblk, rank};
        pg8::gemm_phase((PG8_LAS unsigned char*)smem, pg8::Gemm{E2, yt, 256, 256, 256}, S, pg8::EpiE2{tp});
      }
    } else if (sub == 5) {
      for (int it = bid; it < 128 * 16; it += nblk) {
        const int k1 = it >> 4, m0 = (it & 15) * 256;
        f32x4 acc[4][2];
        zero_acc<4, 2>(acc);
        gemm_main<4, 2, false>(acc, RowLin{tp + (size_t)k1 * 128, 128 * 128}, m0, E3 + (size_t)k1 * 64 * 128, 128, 0, 128, smem);
        gemm_epi<4, 2, false>(acc, m0, 0, [&](int m, int n, f32x4 v, int, int) {
          const int b = m >> 10, g = (m >> 8) & 3, cp = m & 255;
          *(uint2*)(ob + ((size_t)b * SEQ + k1 + 128 * n) * DM + g * 256 + cp) = pk4(v);
        });
      }
    } else if (sub == 6) {
      {
        pg8::Order<4> S{12, 128 * 12, nblk, rank};
        pg8::gemm_phase((PG8_LAS unsigned char*)smem, pg8::Gemm{hbuf, W + W_IN + (size_t)ZS * 1024, DM, 1024, 1024}, S, pg8::EpiSigmoid{gbuf, 3072});
      }
    } else if (sub == 7) {
      for (int v = rank; v < 128 * 8; v += nblk) {
        int pm, pn; tile_of<4>(v, 8, pm, pn);
        const int m0 = pm * 256, n0 = pn * 128;
        f32x4 macc[4][4], acc[4][4];
        zero_acc<4, 4>(macc);
        const int tid_ = otid(), ln = tid_ & 63, wv = tid_ >> 6;
        const int wm = wv >> 1, wn = wv & 1;
#pragma unroll 1
        for (int br = 0; br < 3; ++br) {
          const u16* ab = br == 0 ? oa : (br == 1 ? ob : oc);
          const int lda = br == 1 ? 1024 : 512;
          const u16* wb = W + (br == 0 ? W_A : (br == 1 ? W_B : W_C));
          zero_acc<4, 4>(acc);
          uint2 gv[4][4];
#pragma unroll
          for (int i = 0; i < 4; ++i)
#pragma unroll
            for (int j = 0; j < 4; ++j) {
              const int m = m0 + wm * 64 + i * 16 + (ln & 15);
              const int n = n0 + wn * 64 + j * 16 + (ln >> 4) * 4;
              gv[i][j] = *(const uint2*)(gbuf + (size_t)m * 3072 + br * 1024 + n);
            }
          __builtin_amdgcn_sched_barrier(0);
          gemm_main<4, 4, true, false>(acc, RowLin{ab, lda}, m0, wb, lda, n0, lda, smem);
#pragma unroll
          for (int i = 0; i < 4; ++i)
#pragma unroll
            for (int j = 0; j < 4; ++j) {
              macc[i][j][0] += bflo(gv[i][j].x) * acc[i][j][0];
              macc[i][j][1] += bfhi(gv[i][j].x) * acc[i][j][1];
              macc[i][j][2] += bflo(gv[i][j].y) * acc[i][j][2];
              macc[i][j][3] += bfhi(gv[i][j].y) * acc[i][j][3];
            }
        }
#pragma unroll
        for (int i = 0; i < 4; ++i)
#pragma unroll
          for (int j = 0; j < 4; ++j) {
            const int m = m0 + wm * 64 + i * 16 + (ln & 15);
            const int n = n0 + wn * 64 + j * 16 + (ln >> 4) * 4;
            *(uint2*)(merged + (size_t)m * DM + n) = pk4(macc[i][j]);
          }
      }
    } else if (sub == 8) {
      {
        pg8::Order<8> S{4, 128 * 4, nblk, rank};
        pg8::gemm_phase((PG8_LAS unsigned char*)smem, pg8::Gemm{merged, W + W_OUT, DM, 1024, 1024}, S, pg8::EpiStore{ybuf, DM});
      }
    } else if (sub == 9) {
      const int wave = otid() >> 6;
      rowpass_pipe(bid * 8 + wave, nblk * 8, NTOK, x16, ybuf, p.in[14] + layer * DM, nullptr, x16, p.in[15] + layer * DM, hbuf);
    } else if (sub == 10) {
      {
        pg8::Order<4> S{22, 128 * 22, nblk, rank};
        pg8::gemm_phase((PG8_LAS unsigned char*)smem, pg8::Gemm{hbuf, W + W_FG, DM, 1024, 1024}, S, pg8::EpiSwiGLU{hid, FFN});
      }
    } else if (sub == 11) {
      {
        pg8::Order<8> S{4, 128 * 4, nblk, rank};
        pg8::gemm_phase((PG8_LAS unsigned char*)smem, pg8::Gemm{hid, W + W_FD, FFN, FFN, FFN}, S, pg8::EpiStore{ff, DM});
      }
    } else if (sub == 12) {
      const int wave = otid() >> 6;
      rowpass_pipe(bid * 8 + wave, nblk * 8, NTOK, x16, ff, p.in[19] + layer * DM, nullptr, nullptr, nullptr, hbuf);
    } else if (sub == 13) {
      for (int v = rank; v < 128 * 8; v += nblk) {
        int pm, pn; tile_of<4>(v, 8, pm, pn);
        const int m0 = pm * 256, n0 = pn * 128;
        f32x4 acc[4][4], acc2[4][4];
        zero_acc<4, 4>(acc);
        zero_acc<4, 4>(acc2);
        gemm_main<4, 4, true>(acc, RowLin{pb + (size_t)layer * NTOK * PLE, PLE}, m0, W + W_PLE, 256, n0, 256, smem);
        gemm_main<4, 4, true>(acc2, RowLin{hbuf, DM}, m0, W + W_PG, 1024, n0, 1024, smem);
        const int tid_ = otid(), ln = tid_ & 63, wv = tid_ >> 6;
        const int wm = wv >> 1, wn = wv & 1;
#pragma unroll
        for (int i = 0; i < 4; ++i)
#pragma unroll
          for (int j = 0; j < 4; ++j) {
            const int m = m0 + wm * 64 + i * 16 + (ln & 15);
            const int n = n0 + wn * 64 + j * 16 + (ln >> 4) * 4;
            f32x4 vv = acc[i][j], u = acc2[i][j], r;
#pragma unroll
            for (int q = 0; q < 4; ++q) r[q] = vv[q] * fsigmoid(u[q]);
            *(uint2*)(ebuf + (size_t)m * DM + n) = pk4(r);
          }
      }
    } else {
      const bool last = (layer == 1);
      const int wave = otid() >> 6;
      if (last) rowpass_pipe(bid * 8 + wave, nblk * 8, NTOK, hbuf, ebuf, p.in[22] + layer * DM, xout, nullptr, nullptr, nullptr);
      else rowpass_pipe(bid * 8 + wave, nblk * 8, NTOK, hbuf, ebuf, p.in[22] + layer * DM, nullptr, x16, p.in[3] + (layer + 1) * DM, hbuf);
    }
  }
}

extern "C" void kernel_launch(void* const* d_in, const int* in_sizes, int n_in, void* d_out, int out_size, void* d_ws, size_t ws_size,
                              hipStream_t stream) {
  static int grid = 0;
  if (grid == 0) {
    int dev = 0, cus = 0, per_cu = 0;
    (void)hipGetDevice(&dev);
    (void)hipDeviceGetAttribute(&cus, hipDeviceAttributeMultiprocessorCount, dev);
    if (hipFuncSetAttribute((const void*)mega, hipFuncAttributeMaxDynamicSharedMemorySize, LDS_BYTES) != hipSuccess) {
      fprintf(stderr, "hipFuncSetAttribute failed\n");
    }
    (void)hipOccupancyMaxActiveBlocksPerMultiprocessor(&per_cu, (const void*)mega, NTHR, LDS_BYTES);
    if (per_cu < 1) per_cu = 1;
    grid = cus * per_cu;
    if (ws_size < WS_NEED) fprintf(stderr, "workspace too small: %zu < %zu\n", ws_size, (size_t)WS_NEED);
    (void)hipGetLastError();
  }
  Params p{};
  for (int i = 0; i < 23; ++i) p.in[i] = (const float*)d_in[i];
  p.pos = (const int*)d_in[2];
  p.out = (float*)d_out;
  p.ws = (unsigned char*)d_ws;
  p.ph_lo = 0;
  p.ph_hi = 31;
  void* args[] = {&p};
  (void)hipMemsetAsync((char*)d_ws + OFF_CNT, 0, XB_WORDS * 4, stream);
  hipError_t e = hipLaunchCooperativeKernel((const void*)mega, dim3(grid), dim3(NTHR), args, LDS_BYTES, stream);
  if (e != hipSuccess) fprintf(stderr, "cooperative launch failed: %s (grid %d)\n", hipGetErrorString(e), grid);
}
```

```cpp
#include <hip/hip_runtime.h>
#include <hip/hip_cooperative_groups.h>
#include <cstdio>
namespace cg = cooperative_groups;

#define DI __device__ __forceinline__
typedef unsigned short u16;
typedef short bf16x8 __attribute__((ext_vector_type(8)));
typedef short s16x4 __attribute__((ext_vector_type(4)));
typedef float f32x4 __attribute__((ext_vector_type(4)));
typedef float f32x16 __attribute__((ext_vector_type(16)));
typedef float f2v __attribute__((ext_vector_type(2)));
typedef __bf16 b2v __attribute__((ext_vector_type(2)));

constexpr int NTOK = 32768, DM = 1024, SEQ = 8192, NB = 4;
constexpr int INC = 4384, ZS = 1312, FFN = 2816, PLE = 256;
constexpr int NTHR = 512;
constexpr float EPS = 1e-6f;
constexpr float LOG2E = 1.4426950408889634f;

constexpr size_t W_IN = 0;
constexpr size_t W_UQ = W_IN + (size_t)INC * 1024;
constexpr size_t W_UKV = W_UQ + 768 * 384;
constexpr size_t W_A = W_UKV + 1024 * 128;
constexpr size_t W_B = W_A + 1024 * 512;
constexpr size_t W_C = W_B + 1024 * 1024;
constexpr size_t W_OUT = W_C + 1024 * 512;
constexpr size_t W_FG = W_OUT + 1024 * 1024;
constexpr size_t W_FU = W_FG + (size_t)FFN * 1024;
constexpr size_t W_FD = W_FU + (size_t)FFN * 1024;
constexpr size_t W_PLE = W_FD + (size_t)FFN * 1024;
constexpr size_t W_PG = W_PLE + 1024 * 256;
constexpr size_t W_LAYER = W_PG + 1024 * 1024;
constexpr int WT_ITEMS_LAYER = 1104 + 72 + 32 + 128 + 256 + 128 + 256 + 704 + 704 + 704 + 64 + 256;

constexpr size_t MiB = 1ull << 20;
constexpr size_t OFF_W = 0;
constexpr size_t OFF_E1 = 69 * MiB;
constexpr size_t OFF_E2 = OFF_E1 + 512 * 256 * 2;
constexpr size_t OFF_E3 = OFF_E2 + 256 * 256 * 2;
constexpr size_t OFF_CNT = 69 * MiB + 4 * MiB + 512 * 1024;
constexpr size_t OFF_ROPE = 74 * MiB;
constexpr size_t OFF_PB = 78 * MiB;
constexpr size_t OFF_H = 110 * MiB;
constexpr size_t OFF_OA = 174 * MiB;
constexpr size_t OFF_OC = 206 * MiB;
constexpr size_t OFF_R = 238 * MiB;
constexpr size_t WS_NEED = OFF_R + 256 * MiB;
constexpr size_t R_ZS = OFF_R;
constexpr size_t R_QM = OFF_R + 82 * MiB;
constexpr size_t R_KF = OFF_R + 130 * MiB;
constexpr size_t R_VT = OFF_R + 178 * MiB;
constexpr size_t R_VTC = OFF_R + 210 * MiB;
constexpr size_t R_YT = OFF_R;
constexpr size_t R_TP = OFF_R + 128 * MiB;
constexpr size_t R_OB = OFF_R;
constexpr size_t R_GATE = OFF_R + 64 * MiB;
constexpr size_t R_Y = OFF_R + 192 * MiB;
constexpr size_t R_HID = OFF_R;
constexpr size_t R_FF = OFF_R + 176 * MiB;
constexpr size_t R_E = OFF_R;

constexpr int LDS_ROW = 144;
constexpr int LDS_A = 256 * 128;
constexpr int LDS_B = 256 * 128;
constexpr int LDS_STAGE = LDS_A + LDS_B;
constexpr int LDS_STG3 = LDS_A + 128 * 128;
constexpr int LDS_AUX = 3 * LDS_STG3;
constexpr int LDS_CTL = LDS_AUX + 1024;
constexpr int LDS_BYTES = LDS_CTL + 64;

struct Params {
  const float* in[23];
  const int* pos;
  float* out;
  unsigned char* ws;
  int ph_lo, ph_hi;
};

DI int otid() { int t = threadIdx.x; asm volatile("" : "+v"(t)); return t; }
DI int xcd_lin(int v) { return (v & ~255) | ((v & 7) << 5) | ((v >> 3) & 31); }
template <int GM> DI void tile_of(int L, int TN, int& pm, int& pn) { const int nig = GM * TN, gid = L / nig, w = L % nig; pm = gid * GM + (w % GM); pn = w / GM; }
DI unsigned pk2(float a, float b) { f2v v = {a, b}; b2v r = __builtin_convertvector(v, b2v); return __builtin_bit_cast(unsigned, r); }
DI u16 f2bf(float a) { return (u16)(pk2(a, 0.f) & 0xffffu); }
DI float bflo(unsigned u) { return __uint_as_float(u << 16); }
DI float bfhi(unsigned u) { return __uint_as_float(u & 0xffff0000u); }
DI float bf2f(u16 v) { return __uint_as_float(((unsigned)v) << 16); }
DI float fexp2(float x) { return __builtin_amdgcn_exp2f(x); }
DI float frcp(float x) { return __builtin_amdgcn_rcpf(x); }
DI float fsigmoid(float x) { return frcp(1.f + fexp2(-x * LOG2E)); }
DI float cos_rev(float r) { return __builtin_amdgcn_cosf(r); }
DI float sin_rev(float r) { return __builtin_amdgcn_sinf(r); }
DI float wave_sum(float v) {
#pragma unroll
  for (int o = 32; o >= 1; o >>= 1) v += __shfl_xor(v, o, 64);
  return v;
}
DI uint2 pk4(f32x4 v) { uint2 r; r.x = pk2(v[0], v[1]); r.y = pk2(v[2], v[3]); return r; }

template <int MT, int NT, bool SWAP, bool PIPE = true, class ARow = void>
DI void gemm_main(f32x4 (&acc)[MT][NT], ARow arow, int m0, const u16* __restrict__ Bt, int ldb, int n0, int K, char* smem) {
  static_assert(MT == 2 || MT == 4, "MT");
  static_assert(NT == 2 || NT == 4 || NT == 8, "NT");
  typedef __attribute__((address_space(3))) unsigned int lds_u32;
  const int tid = otid(), lane = tid & 63;
  const int wave = __builtin_amdgcn_readfirstlane(tid >> 6);
  const int wm = wave >> 1, wn = wave & 1;
  const int srow = wave * 8 + (lane >> 3);
  const int schunk = (lane & 7) ^ (((wave & 1) * 4 + (lane >> 4)) & 7);
  const u16* pa0 = arow(m0 + srow) + schunk * 8;
  const u16* pa1 = arow(m0 + srow + 64) + schunk * 8;
  const u16* pa2 = MT > 2 ? arow(m0 + srow + 128) + schunk * 8 : pa0;
  const u16* pa3 = MT > 2 ? arow(m0 + srow + 192) + schunk * 8 : pa0;
  const u16* pb0 = Bt + (size_t)(n0 + srow) * ldb + schunk * 8;
  const u16* pb1 = NT > 2 ? Bt + (size_t)(n0 + srow + 64) * ldb + schunk * 8 : pb0;
  const u16* pb2 = NT > 4 ? Bt + (size_t)(n0 + srow + 128) * ldb + schunk * 8 : pb0;
  const u16* pb3 = NT > 4 ? Bt + (size_t)(n0 + srow + 192) * ldb + schunk * 8 : pb0;
  const int nk = K >> 6;
  lds_u32* lbase = (lds_u32*)(smem);
  const int wofs = wave * 1024;
#define G_LDS(p, byteoff) __builtin_amdgcn_global_load_lds((const unsigned int*)(p), (lds_u32*)((__attribute__((address_space(3))) char*)lbase + (byteoff)), 16, 0, 0)
#define G_STAGE(stg, k0)                                                           \
  do {                                                                             \
    const int so_ = (stg) * STG + wofs;                                            \
    G_LDS(pa0 + (k0), so_);                                                        \
    G_LDS(pa1 + (k0), so_ + 8192);                                                 \
    if (MT > 2) { G_LDS(pa2 + (k0), so_ + 16384); G_LDS(pa3 + (k0), so_ + 24576); } \
    G_LDS(pb0 + (k0), so_ + LDS_A);                                                \
    if (NT > 2) G_LDS(pb1 + (k0), so_ + LDS_A + 8192);                             \
    if (NT > 4) { G_LDS(pb2 + (k0), so_ + LDS_A + 16384); G_LDS(pb3 + (k0), so_ + LDS_A + 24576); } \
  } while (0)
  constexpr bool RING3 = NT <= 4;
  constexpr int STG = RING3 ? LDS_STG3 : LDS_STAGE;
  constexpr int NLD = MT + NT / 2;
#define G_WAIT_PREV()                                                                                  \
  do {                                                                                                 \
    if (!RING3) asm volatile("s_waitcnt vmcnt(0)" ::: "memory");                                       \
    else if (NLD == 4) asm volatile("s_waitcnt vmcnt(4)" ::: "memory");                                \
    else if (NLD == 5) asm volatile("s_waitcnt vmcnt(5)" ::: "memory");                                \
    else asm volatile("s_waitcnt vmcnt(6)" ::: "memory");                                              \
    asm volatile("s_waitcnt lgkmcnt(0)" ::: "memory");                                                 \
    __builtin_amdgcn_s_barrier();                                                                      \
    asm volatile("" ::: "memory");                                                                     \
  } while (0)
  static_assert(!RING3 || NLD == 4 || NLD == 5 || NLD == 6, "NLD");
  G_STAGE(0, 0);
  if (RING3) G_STAGE(1, (nk > 1 ? 1 : 0) << 6);
  G_WAIT_PREV();
  const int xq = ((lane >> 4) ^ ((lane & 15) >> 1)) * 16;
  const int fa_off = (wm * 16 * MT + (lane & 15)) * 128;
  const int fb_off = LDS_A + (wn * 16 * NT + (lane & 15)) * 128;
  int scur = 0;
  for (int kt = 0; kt < nk; ++kt) {
    const bool pf = RING3 ? (kt + 2 < nk) : (kt + 1 < nk);
    if (pf) {
      if (RING3) { const int s2 = scur == 0 ? 2 : scur - 1; G_STAGE(s2, (kt + 2) << 6); }
      else G_STAGE(scur ^ 1, (kt + 1) << 6);
    }
    __builtin_amdgcn_sched_barrier(0);
    const char* sb = smem + scur * STG;
    if (!PIPE) {
#pragma unroll
      for (int ks = 0; ks < 2; ++ks) {
        const int xo = xq ^ (ks * 64);
        bf16x8 af[MT], bfr[NT];
#pragma unroll
        for (int i = 0; i < MT; ++i) af[i] = *(const bf16x8*)(sb + fa_off + i * 2048 + xo);
#pragma unroll
        for (int j = 0; j < NT; ++j) bfr[j] = *(const bf16x8*)(sb + fb_off + j * 2048 + xo);
#pragma unroll
        for (int i = 0; i < MT; ++i)
#pragma unroll
          for (int j = 0; j < NT; ++j) {
            if (SWAP) acc[i][j] = __builtin_amdgcn_mfma_f32_16x16x32_bf16(bfr[j], af[i], acc[i][j], 0, 0, 0);
            else acc[i][j] = __builtin_amdgcn_mfma_f32_16x16x32_bf16(af[i], bfr[j], acc[i][j], 0, 0, 0);
          }
      }
    } else {
      constexpr int JG = NT < 4 ? NT : 4;
      constexpr int NG = NT / JG, NSTEP = 2 * NG;
      bf16x8 afr[2][MT], bgr[2][JG];
#pragma unroll
      for (int i = 0; i < MT; ++i) afr[0][i] = *(const bf16x8*)(sb + fa_off + i * 2048 + xq);
#pragma unroll
      for (int j = 0; j < JG; ++j) bgr[0][j] = *(const bf16x8*)(sb + fb_off + j * 2048 + xq);
#pragma unroll
      for (int t = 0; t < NSTEP; ++t) {
        const int ks = t / NG, jg = (t % NG) * JG;
        if (t + 1 < NSTEP) {
          const int ks1 = (t + 1) / NG, jg1 = ((t + 1) % NG) * JG;
          const int xo1 = xq ^ (ks1 * 64);
          if (ks1 != ks) {
#pragma unroll
            for (int i = 0; i < MT; ++i) afr[ks1 & 1][i] = *(const bf16x8*)(sb + fa_off + i * 2048 + xo1);
          }
#pragma unroll
          for (int j = 0; j < JG; ++j) bgr[(t + 1) & 1][j] = *(const bf16x8*)(sb + fb_off + (jg1 + j) * 2048 + xo1);
        }
        __builtin_amdgcn_sched_barrier(0);
#pragma unroll
        for (int i = 0; i < MT; ++i)
#pragma unroll
          for (int j = 0; j < JG; ++j) {
            if (SWAP) acc[i][jg + j] = __builtin_amdgcn_mfma_f32_16x16x32_bf16(bgr[t & 1][j], afr[ks & 1][i], acc[i][jg + j], 0, 0, 0);
            else acc[i][jg + j] = __builtin_amdgcn_mfma_f32_16x16x32_bf16(afr[ks & 1][i], bgr[t & 1][j], acc[i][jg + j], 0, 0, 0);
          }
      }
    }
    __builtin_amdgcn_sched_barrier(0);
    if (pf) G_WAIT_PREV();
    else {
      asm volatile("s_waitcnt vmcnt(0)" ::: "memory");
      asm volatile("s_waitcnt lgkmcnt(0)" ::: "memory");
      __builtin_amdgcn_s_barrier();
      asm volatile("" ::: "memory");
    }
    scur = RING3 ? (scur == 2 ? 0 : scur + 1) : (scur ^ 1);
  }
#undef G_WAIT_PREV
#undef G_LDS
#undef G_STAGE
}

template <int MT, int NT>
DI void zero_acc(f32x4 (&acc)[MT][NT]) {
#pragma unroll
  for (int i = 0; i < MT; ++i)
#pragma unroll
    for (int j = 0; j < NT; ++j) acc[i][j] = f32x4{0.f, 0.f, 0.f, 0.f};
}

template <int MT, int NT, bool SWAP, class F>
DI void gemm_epi(f32x4 (&acc)[MT][NT], int m0, int n0, F f) {
  const int tid_ = otid(); const int lane = tid_ & 63, wave = tid_ >> 6;
  const int wm = wave >> 1, wn = wave & 1;
#pragma unroll
  for (int i = 0; i < MT; ++i)
#pragma unroll
    for (int j = 0; j < NT; ++j) {
      int m, n;
      if (SWAP) { m = m0 + wm * 16 * MT + i * 16 + (lane & 15); n = n0 + wn * 16 * NT + j * 16 + (lane >> 4) * 4; }
      else { m = m0 + wm * 16 * MT + i * 16 + (lane >> 4) * 4; n = n0 + wn * 16 * NT + j * 16 + (lane & 15); }
      f(m, n, acc[i][j], i, j);
    }
}

struct RowLin {
  const u16* base; int ld;
  DI const u16* operator()(int m) const { return base + (size_t)m * ld; }
};

namespace pg8 {
#define PG8_LAS __attribute__((address_space(3)))
constexpr int BM = 256, BK = 64, HALF = 128, HTB = HALF * BK * 2;
DI int lds_byte(int r, int c) { const int st = (r >> 4) * 2 + (c >> 5), rr = r & 15, cc = c & 31, ob = rr * 64 + cc * 2; return st * 1024 + (ob ^ (((ob >> 9) & 1) << 5)); }
DI void stage_rc(int b, int& R, int& C) { const int st = b / 1024, sb = b % 1024, swz = sb ^ (((sb >> 9) & 1) << 5); R = (st >> 1) * 16 + swz / 64; C = (st & 1) * 32 + (swz % 64) / 2; }
struct Unit { int pm, pn; };
struct Gemm { const u16* A; const u16* Bt; int lda, ldb, K; };
template <int GM> struct Order {
  int nN, nunits, G, c;
  DI bool next(int i, Unit& u) const {
    const int L = c + i * G;
    if (L >= nunits) return false;
    tile_of<GM>(L, nN, u.pm, u.pn);
    return true;
  }
};
template <class Epi, class Sched>
DI void gemm_phase(PG8_LAS unsigned char* lds, const Gemm g, const Sched& S, const Epi& E) {
  const int tid = otid(), wid = __builtin_amdgcn_readfirstlane(tid >> 6), lane = tid & 63, wr = wid >> 2, wc = wid & 3, fr = lane & 15, fq = lane >> 4;
  const int K = g.K, nt = K / BK;
  unsigned voffA[2], voffB[2];
#pragma unroll
  for (int i = 0; i < 2; ++i) { int R, C; stage_rc(tid * 16 + i * 8192, R, C); voffA[i] = (unsigned)(R * g.lda + C) * 2u; voffB[i] = (unsigned)(R * g.ldb + C) * 2u; }
  const size_t kstep = (size_t)(BK * 2);
  const size_t hstepA = (size_t)HALF * g.lda * 2, hstepB = (size_t)HALF * g.ldb * 2;
  const size_t tstepA = 2 * hstepA, tstepB = 2 * hstepB;
  const unsigned ldsw = (unsigned)wid * 1024u;
  const int aoff = lds_byte(wr * 64 + fr, fq * 8), boff = lds_byte(wc * 32 + fr, fq * 8);
#define PG8_SA(b, h) (((b) * 2 + (h)) * HTB)
#define PG8_SB(b, h) ((4 + (b) * 2 + (h)) * HTB)
#define PG8_STAGE(bufoff, gbase, voff) do { _Pragma("unroll") for (int _i = 0; _i < 2; ++_i) \
        __builtin_amdgcn_global_load_lds((const unsigned*)((const char*)(gbase) + (voff)[_i]), (PG8_LAS unsigned*)(lds + (bufoff) + ldsw + _i * 8192), 16, 0, 0); } while (0)
#define PG8_LDA(dst, b, h) do { _Pragma("unroll") for (int m = 0; m < 4; ++m) _Pragma("unroll") for (int k = 0; k < 2; ++k) dst[m][k] = *(const PG8_LAS bf16x8*)(lds + PG8_SA(b, h) + aoff + m * 2048 + k * 1024); } while (0)
#define PG8_LDB(dst, b, h) do { _Pragma("unroll") for (int n = 0; n < 2; ++n) _Pragma("unroll") for (int k = 0; k < 2; ++k) dst[n][k] = *(const PG8_LAS bf16x8*)(lds + PG8_SB(b, h) + boff + n * 2048 + k * 1024); } while (0)
#define PG8_MMA(ai, bj, At, Bt) do { __builtin_amdgcn_s_setprio(1); _Pragma("unroll") for (int m = 0; m < 4; ++m) _Pragma("unroll") for (int n = 0; n < 2; ++n) _Pragma("unroll") for (int k = 0; k < 2; ++k) \
        acc[ai][bj][m][n] = __builtin_amdgcn_mfma_f32_16x16x32_bf16(Bt[n][k], At[m][k], acc[ai][bj][m][n], 0, 0, 0); __builtin_amdgcn_s_setprio(0); } while (0)
#define PG8_WAIT_V(n) asm volatile("s_waitcnt vmcnt(" #n ")" ::: "memory")
#define PG8_WAIT_L(n) asm volatile("s_waitcnt lgkmcnt(" #n ")" ::: "memory")
#define PG8_BAR __builtin_amdgcn_s_barrier()
#define PG8_SCHED __builtin_amdgcn_sched_barrier(0)
  Unit cur, nxt; int ui = 0;
  if (!S.next(0, cur)) return;
  f32x4 acc[2][2][4][2];
#pragma unroll
  for (int a = 0; a < 2; ++a)
#pragma unroll
    for (int b = 0; b < 2; ++b)
#pragma unroll
      for (int m = 0; m < 4; ++m)
#pragma unroll
        for (int n = 0; n < 2; ++n) acc[a][b][m][n] = (f32x4){0.f, 0.f, 0.f, 0.f};
  bf16x8 At[4][2], B0[2][2], B1[2][2];
  const char* cA = (const char*)g.A + (size_t)cur.pm * tstepA; const char* cB = (const char*)g.Bt + (size_t)cur.pn * tstepB;
  PG8_STAGE(PG8_SB(0, 0), cB, voffB); PG8_STAGE(PG8_SA(0, 0), cA, voffA); PG8_STAGE(PG8_SB(0, 1), cB + hstepB, voffB); PG8_STAGE(PG8_SA(0, 1), cA + hstepA, voffA);
  if (wr == 1) PG8_BAR;
  PG8_WAIT_V(4); PG8_BAR;
  PG8_STAGE(PG8_SB(1, 0), cB + kstep, voffB); PG8_STAGE(PG8_SA(1, 0), cA + kstep, voffA); PG8_STAGE(PG8_SB(1, 1), cB + hstepB + kstep, voffB);
  PG8_WAIT_V(6); PG8_BAR;
  for (;;) {
    const bool has_next = S.next(ui + 1, nxt);
    const char* nA = has_next ? (const char*)g.A + (size_t)nxt.pm * tstepA : cA; const char* nB = has_next ? (const char*)g.Bt + (size_t)nxt.pn * tstepB : cB;
    for (int t = 0; t < nt; t += 2) {
      const bool last = (t == nt - 2);
      const char* a1 = cA + (size_t)(t + 1) * kstep;
      const char* a2 = last ? nA : cA + (size_t)(t + 2) * kstep; const char* b2 = last ? nB : cB + (size_t)(t + 2) * kstep;
      const char* a3 = a2 + kstep; const char* b3 = b2 + kstep;
      PG8_LDB(B0, 0, 0); PG8_SCHED; PG8_LDA(At, 0, 0); PG8_STAGE(PG8_SA(1, 1), a1 + hstepA, voffA);
      PG8_WAIT_L(8); PG8_BAR; PG8_WAIT_L(0); PG8_MMA(0, 0, At, B0); PG8_BAR; PG8_SCHED;
      PG8_LDB(B1, 0, 1); PG8_STAGE(PG8_SB(0, 0), b2, voffB);
      PG8_BAR; PG8_WAIT_L(0); PG8_MMA(0, 1, At, B1); PG8_BAR;
      PG8_LDA(At, 0, 1); PG8_STAGE(PG8_SA(0, 0), a2, voffA);
      PG8_BAR; PG8_WAIT_L(0); PG8_MMA(1, 0, At, B0); PG8_BAR; PG8_SCHED;
      PG8_STAGE(PG8_SB(0, 1), b2 + hstepB, voffB);
      PG8_WAIT_V(6); PG8_BAR; PG8_MMA(1, 1, At, B1); PG8_BAR;
      PG8_LDB(B0, 1, 0); PG8_SCHED; PG8_LDA(At, 1, 0); PG8_STAGE(PG8_SA(0, 1), a2 + hstepA, voffA);
      PG8_WAIT_L(8); PG8_BAR; PG8_WAIT_L(0); PG8_MMA(0, 0, At, B0); PG8_BAR; PG8_SCHED;
      PG8_LDB(B1, 1, 1); PG8_STAGE(PG8_SB(1, 0), b3, voffB);
      PG8_BAR; PG8_WAIT_L(0); PG8_MMA(0, 1, At, B1); PG8_BAR;
      PG8_LDA(At, 1, 1); PG8_STAGE(PG8_SA(1, 0), a3, voffA);
      PG8_BAR; PG8_WAIT_L(0); PG8_MMA(1, 0, At, B0); PG8_BAR; PG8_SCHED;
      PG8_STAGE(PG8_SB(1, 1), b3 + hstepB, voffB);
      PG8_WAIT_V(6); PG8_BAR; PG8_MMA(1, 1, At, B1); PG8_BAR;
    }
    E(acc, cur, wr, wc, fr, fq);
    if (!has_next) break;
#pragma unroll
    for (int a = 0; a < 2; ++a)
#pragma unroll
      for (int b = 0; b < 2; ++b)
#pragma unroll
        for (int m = 0; m < 4; ++m)
#pragma unroll
          for (int n = 0; n < 2; ++n) acc[a][b][m][n] = (f32x4){0.f, 0.f, 0.f, 0.f};
    cur = nxt; cA = nA; cB = nB; ++ui;
  }
  PG8_WAIT_V(0);
  if (wr == 0) PG8_BAR;
  PG8_BAR;
#undef PG8_SA
#undef PG8_SB
#undef PG8_STAGE
#undef PG8_LDA
#undef PG8_LDB
#undef PG8_MMA
#undef PG8_WAIT_V
#undef PG8_WAIT_L
#undef PG8_BAR
#undef PG8_SCHED
}
struct EpiStore {
  u16* C; int ldc;
  DI void operator()(const f32x4 (&acc)[2][2][4][2], const Unit& u, int wr, int wc, int fr, int fq) const {
#pragma unroll
    for (int ai = 0; ai < 2; ++ai)
#pragma unroll
      for (int m = 0; m < 4; ++m) {
        u16* rowp = C + (size_t)(u.pm * BM + ai * HALF + wr * 64 + m * 16 + fr) * ldc + u.pn * BM + wc * 32 + 4 * fq;
#pragma unroll
        for (int bj = 0; bj < 2; ++bj)
#pragma unroll
          for (int n = 0; n < 2; ++n) *(uint2*)(rowp + bj * HALF + n * 16) = pk4(acc[ai][bj][m][n]);
      }
  }
};
struct EpiSwiGLU {
  u16* C; int ldc;
  DI void operator()(const f32x4 (&acc)[2][2][4][2], const Unit& u, int wr, int wc, int fr, int fq) const {
#pragma unroll
    for (int ai = 0; ai < 2; ++ai)
#pragma unroll
      for (int m = 0; m < 4; ++m) {
        u16* rowp = C + (size_t)(u.pm * BM + ai * HALF + wr * 64 + m * 16 + fr) * ldc + u.pn * HALF + wc * 32 + 4 * fq;
#pragma unroll
        for (int n = 0; n < 2; ++n) {
          const f32x4 gv = acc[ai][0][m][n], uv = acc[ai][1][m][n];
          f32x4 r;
#pragma unroll
          for (int q = 0; q < 4; ++q) r[q] = gv[q] * fsigmoid(gv[q]) * uv[q];
          *(uint2*)(rowp + n * 16) = pk4(r);
        }
      }
  }
};
struct EpiZs {
  u16* zs; u16* vtc;
  DI void operator()(const f32x4 (&acc)[2][2][4][2], const Unit& u, int wr, int wc, int fr, int fq) const {
#pragma unroll
    for (int ai = 0; ai < 2; ++ai)
#pragma unroll
      for (int m = 0; m < 4; ++m) {
        const int row = u.pm * BM + ai * HALF + wr * 64 + m * 16 + fr;
#pragma unroll
        for (int bj = 0; bj < 2; ++bj)
#pragma unroll
          for (int n = 0; n < 2; ++n) {
            const int col = u.pn * BM + bj * HALF + wc * 32 + n * 16 + 4 * fq;
            const f32x4 v = acc[ai][bj][m][n];
            if (col < 1184) {
              *(uint2*)(zs + (size_t)row * ZS + col) = pk4(v);
            } else if (col < ZS) {
              const int c = col - 1184, kvh = c >> 6, d = c & 63, b = row >> 13, s = row & 8191;
              u16* q = vtc + ((size_t)(b * 2 + kvh) * 64 + d) * SEQ + s;
              q[0] = f2bf(v[0]); q[SEQ] = f2bf(v[1]); q[2 * SEQ] = f2bf(v[2]); q[3 * SEQ] = f2bf(v[3]);
            }
          }
      }
  }
};
struct EpiE2 {
  u16* tp;
  DI void operator()(const f32x4 (&acc)[2][2][4][2], const Unit& u, int wr, int wc, int fr, int fq) const {
#pragma unroll
    for (int ai = 0; ai < 2; ++ai)
#pragma unroll
      for (int m = 0; m < 4; ++m) {
        const int tr = ai * HALF + wr * 64 + m * 16 + fr, comp = tr >> 7, k1 = tr & 127;
#pragma unroll
        for (int bj = 0; bj < 2; ++bj)
#pragma unroll
          for (int n = 0; n < 2; ++n) {
            const int R = u.pn * BM + bj * HALF + wc * 32 + n * 16 + 4 * fq;
            *(uint2*)(tp + ((size_t)(R >> 6) * 128 + k1) * 128 + comp * 64 + (R & 63)) = pk4(acc[ai][bj][m][n]);
          }
      }
  }
};
struct EpiSigmoid {
  u16* C; int ldc;
  DI void operator()(const f32x4 (&acc)[2][2][4][2], const Unit& u, int wr, int wc, int fr, int fq) const {
#pragma unroll
    for (int ai = 0; ai < 2; ++ai)
#pragma unroll
      for (int m = 0; m < 4; ++m) {
        u16* rowp = C + (size_t)(u.pm * BM + ai * HALF + wr * 64 + m * 16 + fr) * ldc + u.pn * BM + wc * 32 + 4 * fq;
#pragma unroll
        for (int bj = 0; bj < 2; ++bj)
#pragma unroll
          for (int n = 0; n < 2; ++n) {
            const f32x4 v = acc[ai][bj][m][n];
            f32x4 r;
#pragma unroll
            for (int q = 0; q < 4; ++q) r[q] = fsigmoid(v[q]);
            *(uint2*)(rowp + bj * HALF + n * 16) = pk4(r);
          }
      }
  }
};
}

DI void rowpass(int row, const float* __restrict__ xf, const u16* xb, const u16* __restrict__ y, const float* __restrict__ gy,
                float* __restrict__ xdf, u16* xdb, const float* __restrict__ go, u16* outn) {
  const int lane = otid() & 63;
  float x[16];
  if (xf) {
#pragma unroll
    for (int i = 0; i < 4; ++i) {
      float4 v = *(const float4*)(xf + (size_t)row * DM + i * 256 + lane * 4);
      x[i * 4 + 0] = v.x; x[i * 4 + 1] = v.y; x[i * 4 + 2] = v.z; x[i * 4 + 3] = v.w;
    }
  } else {
#pragma unroll
    for (int i = 0; i < 4; ++i) {
      uint2 u = *(const uint2*)(xb + (size_t)row * DM + i * 256 + lane * 4);
      x[i * 4 + 0] = bflo(u.x); x[i * 4 + 1] = bfhi(u.x); x[i * 4 + 2] = bflo(u.y); x[i * 4 + 3] = bfhi(u.y);
    }
  }
  if (y) {
    float yv[16];
    float ss = 0.f;
#pragma unroll
    for (int i = 0; i < 4; ++i) {
      uint2 u = *(const uint2*)(y + (size_t)row * DM + i * 256 + lane * 4);
      yv[i * 4 + 0] = bflo(u.x); yv[i * 4 + 1] = bfhi(u.x); yv[i * 4 + 2] = bflo(u.y); yv[i * 4 + 3] = bfhi(u.y);
    }
#pragma unroll
    for (int i = 0; i < 16; ++i) ss += yv[i] * yv[i];
    ss = wave_sum(ss);
    const float rs = rsqrtf(ss * (1.f / DM) + EPS);
#pragma unroll
    for (int i = 0; i < 4; ++i) {
      float4 g = *(const float4*)(gy + i * 256 + lane * 4);
      x[i * 4 + 0] += yv[i * 4 + 0] * rs * g.x; x[i * 4 + 1] += yv[i * 4 + 1] * rs * g.y;
      x[i * 4 + 2] += yv[i * 4 + 2] * rs * g.z; x[i * 4 + 3] += yv[i * 4 + 3] * rs * g.w;
    }
  }
  if (xdf) {
#pragma unroll
    for (int i = 0; i < 4; ++i) {
      float4 v = {x[i * 4 + 0], x[i * 4 + 1], x[i * 4 + 2], x[i * 4 + 3]};
      *(float4*)(xdf + (size_t)row * DM + i * 256 + lane * 4) = v;
    }
  }
  float rs = 1.f;
  if (outn && go) {
    float ss = 0.f;
#pragma unroll
    for (int i = 0; i < 16; ++i) ss += x[i] * x[i];
    ss = wave_sum(ss);
    rs = rsqrtf(ss * (1.f / DM) + EPS);
  }
  if (xdb) {
#pragma unroll
    for (int i = 0; i < 4; ++i) {
      uint2 u;
      u.x = pk2(x[i * 4 + 0], x[i * 4 + 1]);
      u.y = pk2(x[i * 4 + 2], x[i * 4 + 3]);
      *(uint2*)(xdb + (size_t)row * DM + i * 256 + lane * 4) = u;
    }
  }
  if (outn) {
#pragma unroll
    for (int i = 0; i < 4; ++i) {
      float4 g = {1.f, 1.f, 1.f, 1.f};
      if (go) g = *(const float4*)(go + i * 256 + lane * 4);
      uint2 u;
      u.x = pk2(x[i * 4 + 0] * rs * g.x, x[i * 4 + 1] * rs * g.y);
      u.y = pk2(x[i * 4 + 2] * rs * g.z, x[i * 4 + 3] * rs * g.w);
      *(uint2*)(outn + (size_t)row * DM + i * 256 + lane * 4) = u;
    }
  }
}

DI void rowpass_pipe(int row, int stride, int nrows, const u16* xb, const u16* __restrict__ y, const float* __restrict__ gy,
                     float* __restrict__ xdf, u16* xdb, const float* __restrict__ go, u16* outn) {
  const int lane = otid() & 63;
  if (row >= nrows) return;
  uint2 cx0, cx1, cx2, cx3, cy0, cy1, cy2, cy3;
#define RP_LOAD(r_, x0, x1, x2, x3, y0, y1, y2, y3)                          \
  do {                                                                       \
    const u16* xp_ = xb + (size_t)(r_) * DM + lane * 4;                      \
    const u16* yp_ = y + (size_t)(r_) * DM + lane * 4;                       \
    x0 = *(const uint2*)(xp_); x1 = *(const uint2*)(xp_ + 256);             \
    x2 = *(const uint2*)(xp_ + 512); x3 = *(const uint2*)(xp_ + 768);       \
    y0 = *(const uint2*)(yp_); y1 = *(const uint2*)(yp_ + 256);             \
    y2 = *(const uint2*)(yp_ + 512); y3 = *(const uint2*)(yp_ + 768);       \
  } while (0)
  RP_LOAD(row, cx0, cx1, cx2, cx3, cy0, cy1, cy2, cy3);
  const float4 gy0 = *(const float4*)(gy + lane * 4), gy1 = *(const float4*)(gy + 256 + lane * 4);
  const float4 gy2 = *(const float4*)(gy + 512 + lane * 4), gy3 = *(const float4*)(gy + 768 + lane * 4);
  float4 go0 = {1.f, 1.f, 1.f, 1.f}, go1 = go0, go2 = go0, go3 = go0;
  if (go) {
    go0 = *(const float4*)(go + lane * 4); go1 = *(const float4*)(go + 256 + lane * 4);
    go2 = *(const float4*)(go + 512 + lane * 4); go3 = *(const float4*)(go + 768 + lane * 4);
  }
  for (; row < nrows; row += stride) {
    const int rn = row + stride < nrows ? row + stride : row;
    uint2 nx0, nx1, nx2, nx3, ny0, ny1, ny2, ny3;
    RP_LOAD(rn, nx0, nx1, nx2, nx3, ny0, ny1, ny2, ny3);
    asm volatile("" ::: "memory");
    __builtin_amdgcn_sched_barrier(0);
    float x[16], yv[16];
    x[0] = bflo(cx0.x); x[1] = bfhi(cx0.x); x[2] = bflo(cx0.y); x[3] = bfhi(cx0.y);
    x[4] = bflo(cx1.x); x[5] = bfhi(cx1.x); x[6] = bflo(cx1.y); x[7] = bfhi(cx1.y);
    x[8] = bflo(cx2.x); x[9] = bfhi(cx2.x); x[10] = bflo(cx2.y); x[11] = bfhi(cx2.y);
    x[12] = bflo(cx3.x); x[13] = bfhi(cx3.x); x[14] = bflo(cx3.y); x[15] = bfhi(cx3.y);
    yv[0] = bflo(cy0.x); yv[1] = bfhi(cy0.x); yv[2] = bflo(cy0.y); yv[3] = bfhi(cy0.y);
    yv[4] = bflo(cy1.x); yv[5] = bfhi(cy1.x); yv[6] = bflo(cy1.y); yv[7] = bfhi(cy1.y);
    yv[8] = bflo(cy2.x); yv[9] = bfhi(cy2.x); yv[10] = bflo(cy2.y); yv[11] = bfhi(cy2.y);
    yv[12] = bflo(cy3.x); yv[13] = bfhi(cy3.x); yv[14] = bflo(cy3.y); yv[15] = bfhi(cy3.y);
    float ss = 0.f;
#pragma unroll
    for (int i = 0; i < 16; ++i) ss += yv[i] * yv[i];
    ss = wave_sum(ss);
    const float rsy = rsqrtf(ss * (1.f / DM) + EPS);
#pragma unroll
    for (int i = 0; i < 4; ++i) {
      const float4 g = i == 0 ? gy0 : (i == 1 ? gy1 : (i == 2 ? gy2 : gy3));
      x[i * 4 + 0] += yv[i * 4 + 0] * rsy * g.x; x[i * 4 + 1] += yv[i * 4 + 1] * rsy * g.y;
      x[i * 4 + 2] += yv[i * 4 + 2] * rsy * g.z; x[i * 4 + 3] += yv[i * 4 + 3] * rsy * g.w;
    }
    if (xdf) {
#pragma unroll
      for (int i = 0; i < 4; ++i) {
        float4 v = {x[i * 4 + 0], x[i * 4 + 1], x[i * 4 + 2], x[i * 4 + 3]};
        *(float4*)(xdf + (size_t)row * DM + i * 256 + lane * 4) = v;
      }
    }
    float rs = 1.f;
    if (outn && go) {
      float s2 = 0.f;
#pragma unroll
      for (int i = 0; i < 16; ++i) s2 += x[i] * x[i];
      s2 = wave_sum(s2);
      rs = rsqrtf(s2 * (1.f / DM) + EPS);
    }
    if (xdb) {
#pragma unroll
      for (int i = 0; i < 4; ++i) {
        uint2 u;
        u.x = pk2(x[i * 4 + 0], x[i * 4 + 1]);
        u.y = pk2(x[i * 4 + 2], x[i * 4 + 3]);
        *(uint2*)(xdb + (size_t)row * DM + i * 256 + lane * 4) = u;
      }
    }
    if (outn) {
#pragma unroll
      for (int i = 0; i < 4; ++i) {
        const float4 g = i == 0 ? go0 : (i == 1 ? go1 : (i == 2 ? go2 : go3));
        uint2 u;
        u.x = pk2(x[i * 4 + 0] * rs * g.x, x[i * 4 + 1] * rs * g.y);
        u.y = pk2(x[i * 4 + 2] * rs * g.z, x[i * 4 + 3] * rs * g.w);
        *(uint2*)(outn + (size_t)row * DM + i * 256 + lane * 4) = u;
      }
    }
    cx0 = nx0; cx1 = nx1; cx2 = nx2; cx3 = nx3; cy0 = ny0; cy1 = ny1; cy2 = ny2; cy3 = ny3;
  }
#undef RP_LOAD
}

DI void wt_tile(const float* __restrict__ src, int K, int N, u16* __restrict__ dst, const float* __restrict__ gain, int tile, int mode, char* smem) {
  float* t = (float*)smem;
  const int ntn = (N + 63) >> 6;
  const int k0 = (tile / ntn) << 6, n0 = (tile % ntn) << 6;
  const int tid = otid();
  {
    const int kk = tid >> 3, ns = (tid & 7) * 8;
    float g = gain ? gain[k0 + kk] : 1.f;
    if (n0 + ns < N) {
      const float* p = src + (size_t)(k0 + kk) * N + n0 + ns;
      float4 a = *(const float4*)p, b = *(const float4*)(p + 4);
      float* d = t + kk * 65 + ns;
      d[0] = a.x * g; d[1] = a.y * g; d[2] = a.z * g; d[3] = a.w * g; d[4] = b.x * g; d[5] = b.y * g; d[6] = b.z * g; d[7] = b.w * g;
    }
  }
  __syncthreads();
  {
    const int n = tid >> 3, ks = (tid & 7) * 8;
    if (n0 + n < N) {
      uint4 o;
      o.x = pk2(t[(ks + 0) * 65 + n], t[(ks + 1) * 65 + n]);
      o.y = pk2(t[(ks + 2) * 65 + n], t[(ks + 3) * 65 + n]);
      o.z = pk2(t[(ks + 4) * 65 + n], t[(ks + 5) * 65 + n]);
      o.w = pk2(t[(ks + 6) * 65 + n], t[(ks + 7) * 65 + n]);
      int nr = n0 + n;
      if (mode) nr = ((nr >> 7) << 8) + (nr & 127) + (mode == 2 ? 128 : 0);
      *(uint4*)(dst + (size_t)nr * K + k0 + ks) = o;
    }
  }
  __syncthreads();
}

template <int DQK, bool WIN>
DI void attn_item(const u16* __restrict__ qbase, int qld,
                  const u16* __restrict__ kbase, int kld,
                  const u16* __restrict__ vtbase,
                  u16* __restrict__ obase, int old_,
                  const float* __restrict__ rope,
                  const int* __restrict__ posb,
                  int q0, float scale2, float slope2, float sink2, char* smem) {
  constexpr int NS = DQK / 16;
  constexpr int KROW = DQK * 2 + 16;
  constexpr int KCH = DQK / 8;
  constexpr int KBYTES = 64 * KROW;
  constexpr int VROW = 144;
  constexpr int VBYTES = 64 * VROW;
  constexpr int ASTAGE = KBYTES + VBYTES + 256;
  const int tid = otid(), lane = tid & 63, wave = tid >> 6;
  const int lq = lane & 31, h2 = lane >> 5;
  const int wq0 = q0 + wave * 32;
  const int tq = wq0 + lq;
  bf16x8 qf[NS];
  {
    const u16* qp = qbase + (size_t)tq * qld;
    if (!WIN) {
#pragma unroll
      for (int s = 0; s < 4; ++s) qf[s] = *(const bf16x8*)(qp + 16 * s + 8 * h2);
      uint4 u1 = *(const uint4*)(qp + 64 + 8 * h2), u2 = *(const uint4*)(qp + 80 + 8 * h2);
      const float* rp = rope + (size_t)tq * 32 + 8 * h2;
      float4 c0 = *(const float4*)(rp), c1 = *(const float4*)(rp + 4), s0 = *(const float4*)(rp + 16), s1 = *(const float4*)(rp + 20);
      float cs[8] = {c0.x, c0.y, c0.z, c0.w, c1.x, c1.y, c1.z, c1.w};
      float sn[8] = {s0.x, s0.y, s0.z, s0.w, s1.x, s1.y, s1.z, s1.w};
      unsigned a1[4] = {u1.x, u1.y, u1.z, u1.w}, a2[4] = {u2.x, u2.y, u2.z, u2.w};
      unsigned r1[4], r2[4];
#pragma unroll
      for (int j = 0; j < 4; ++j) {
        float x1a = bflo(a1[j]), x1b = bfhi(a1[j]), x2a = bflo(a2[j]), x2b = bfhi(a2[j]);
        r1[j] = pk2(x1a * cs[2 * j] - x2a * sn[2 * j], x1b * cs[2 * j + 1] - x2b * sn[2 * j + 1]);
        r2[j] = pk2(x1a * sn[2 * j] + x2a * cs[2 * j], x1b * sn[2 * j + 1] + x2b * cs[2 * j + 1]);
      }
      uint4 o1 = {r1[0], r1[1], r1[2], r1[3]}, o2 = {r2[0], r2[1], r2[2], r2[3]};
      qf[NS - 2] = __builtin_bit_cast(bf16x8, o1);
      qf[NS - 1] = __builtin_bit_cast(bf16x8, o2);
    } else {
#pragma unroll
      for (int s = 0; s < NS; ++s) qf[s] = *(const bf16x8*)(qp + 16 * s + 8 * h2);
    }
  }
  int posq = 0;
  if (WIN) posq = posb[tq];
  f32x16 o[2];
#pragma unroll
  for (int i = 0; i < 16; ++i) { o[0][i] = 0.f; o[1][i] = 0.f; }
  float mrun = WIN ? sink2 : -INFINITY;
  float lsum = 0.f;
  const int ntiles = WIN ? 8 : (SEQ / 64);
  const int kstart = WIN ? (q0 - 128) : 0;
  uint4 rk0, rk1, rv;
  int rp_ = 0;
  rk0 = rk1 = rv = uint4{0, 0, 0, 0};
  const int c1 = tid + 512;
  auto load_tile = [&](int t) {
    const int k0 = kstart + t * 64;
    const bool valid = !WIN || ((k0 >= 0) && (k0 < SEQ));
    if (valid) {
      rk0 = *(const uint4*)(kbase + (size_t)(k0 + tid / KCH) * kld + (tid % KCH) * 8);
      if (KCH == 12 && c1 < 64 * KCH) rk1 = *(const uint4*)(kbase + (size_t)(k0 + c1 / KCH) * kld + (c1 % KCH) * 8);
      rv = *(const uint4*)(vtbase + (size_t)(tid >> 3) * SEQ + k0 + (tid & 7) * 8);
      if (WIN && tid < 64) rp_ = posb[k0 + tid];
    } else {
      rk0 = rk1 = rv = uint4{0, 0, 0, 0};
      rp_ = 0;
    }
  };
  auto store_tile = [&](int stg) {
    char* sb = smem + stg * ASTAGE;
    *(uint4*)(sb + (tid / KCH) * KROW + (tid % KCH) * 16) = rk0;
    if (KCH == 12 && c1 < 64 * KCH) *(uint4*)(sb + (c1 / KCH) * KROW + (c1 % KCH) * 16) = rk1;
    *(uint4*)(sb + KBYTES + (tid >> 3) * VROW + (tid & 7) * 16) = rv;
    if (WIN && tid < 64) *(int*)(sb + KBYTES + VBYTES + tid * 4) = rp_;
  };
  load_tile(0);
  store_tile(0);
  __syncthreads();
  for (int t = 0; t < ntiles; ++t) {
    load_tile(t + 1 < ntiles ? t + 1 : t);
    __builtin_amdgcn_sched_barrier(0);
    const int k0 = kstart + t * 64;
    bool active = true;
    if (WIN) active = (k0 >= 0) && (k0 < SEQ) && (k0 + 63 >= wq0 - 128) && (k0 <= wq0 + 31 + 128);
    if (active) {
      const char* sb = smem + (t & 1) * ASTAGE;
      f32x16 st[2];
#pragma unroll
      for (int kt2 = 0; kt2 < 2; ++kt2) {
#pragma unroll
        for (int i = 0; i < 16; ++i) st[kt2][i] = 0.f;
#pragma unroll
        for (int s = 0; s < NS; ++s) {
          bf16x8 kf = *(const bf16x8*)(sb + (kt2 * 32 + lq) * KROW + s * 32 + h2 * 16);
          st[kt2] = __builtin_amdgcn_mfma_f32_32x32x16_bf16(kf, qf[s], st[kt2], 0, 0, 0);
        }
      }
      float mx = -INFINITY;
      if (WIN) {
        const float posqf = (float)posq;
        const float tqk = (float)(tq - k0 - 4 * h2);
#pragma unroll
        for (int kt2 = 0; kt2 < 2; ++kt2)
#pragma unroll
          for (int g4 = 0; g4 < 4; ++g4) {
            const int4 pk4i = *(const int4*)(sb + KBYTES + VBYTES + (kt2 * 32 + 8 * g4 + 4 * h2) * 4);
            const float pkf[4] = {(float)pk4i.x, (float)pk4i.y, (float)pk4i.z, (float)pk4i.w};
#pragma unroll
            for (int j = 0; j < 4; ++j) {
              const int r = g4 * 4 + j;
              float v = st[kt2][r] * scale2;
              v = __builtin_fmaf(-slope2, __builtin_fabsf(posqf - pkf[j]), v);
              const float e = tqk - (float)(kt2 * 32 + 8 * g4 + j);
              v = (__builtin_fabsf(e) <= 128.f) ? v : -INFINITY;
              st[kt2][r] = v;
              mx = fmaxf(mx, v);
            }
          }
      } else {
#pragma unroll
        for (int kt2 = 0; kt2 < 2; ++kt2)
#pragma unroll
          for (int r = 0; r < 16; ++r) mx = fmaxf(mx, st[kt2][r]);
        mx *= scale2;
      }
      mx = fmaxf(mx, __shfl_xor(mx, 32, 64));
      if (__builtin_amdgcn_ballot_w64(mx > mrun + 8.f) != 0ull) {
        const float mnew = fmaxf(mrun, mx);
        const float alpha = fexp2(mrun - mnew);
        mrun = mnew;
        lsum *= alpha;
#pragma unroll
        for (int i = 0; i < 16; ++i) { o[0][i] *= alpha; o[1][i] *= alpha; }
      }
      float ps = 0.f;
#pragma unroll
      for (int kt2 = 0; kt2 < 2; ++kt2)
#pragma unroll
        for (int r = 0; r < 16; ++r) {
          const float p = WIN ? fexp2(st[kt2][r] - mrun) : fexp2(__builtin_fmaf(st[kt2][r], scale2, -mrun));
          st[kt2][r] = p;
          ps += p;
        }
      lsum += ps;
#pragma unroll
      for (int kt2 = 0; kt2 < 2; ++kt2)
#pragma unroll
        for (int sp = 0; sp < 2; ++sp) {
          uint4 pu;
          pu.x = pk2(st[kt2][8 * sp + 0], st[kt2][8 * sp + 1]);
          pu.y = pk2(st[kt2][8 * sp + 2], st[kt2][8 * sp + 3]);
          pu.z = pk2(st[kt2][8 * sp + 4], st[kt2][8 * sp + 5]);
          pu.w = pk2(st[kt2][8 * sp + 6], st[kt2][8 * sp + 7]);
          const bf16x8 pf = __builtin_bit_cast(bf16x8, pu);
#pragma unroll
          for (int dt = 0; dt < 2; ++dt) {
            const char* vb = sb + KBYTES + (dt * 32 + lq) * VROW + (kt2 * 32 + 16 * sp + 4 * h2) * 2;
            uint2 lo = *(const uint2*)(vb), hi = *(const uint2*)(vb + 16);
            uint4 vu = {lo.x, lo.y, hi.x, hi.y};
            o[dt] = __builtin_amdgcn_mfma_f32_32x32x16_bf16(__builtin_bit_cast(bf16x8, vu), pf, o[dt], 0, 0, 0);
          }
        }
    }
    __builtin_amdgcn_sched_barrier(0);
    store_tile((t + 1) & 1);
    __syncthreads();
  }
  float ltot = lsum + __shfl_xor(lsum, 32, 64);
  if (WIN) ltot += fexp2(sink2 - mrun);
  const float inv = 1.f / ltot;
  u16* op = obase + (size_t)tq * old_;
#pragma unroll
  for (int dt = 0; dt < 2; ++dt)
#pragma unroll
    for (int g = 0; g < 4; ++g) {
      uint2 u;
      u.x = pk2(o[dt][4 * g + 0] * inv, o[dt][4 * g + 1] * inv);
      u.y = pk2(o[dt][4 * g + 2] * inv, o[dt][4 * g + 3] * inv);
      *(uint2*)(op + dt * 32 + 8 * g + 4 * h2) = u;
    }
}

DI void mla_item(const u16* __restrict__ qbase, const u16* __restrict__ kbase, const u16* __restrict__ vtbase, u16* __restrict__ obase,
                 const float* __restrict__ rope, int q0, float scale2, char* smem) {
  constexpr int NS = 6, KROW = 208, KCH = 12, KBYTES = 64 * KROW, VROW = 144, VBYTES = 64 * VROW, ASTAGE = KBYTES + VBYTES;
  constexpr int NT_ = SEQ / 64;
  const int tid = otid(), lane = tid & 63, wave = tid >> 6;
  const int lq = lane & 31, h2 = lane >> 5;
  const int tq = q0 + wave * 32 + lq;
  bf16x8 qf[NS];
  {
    const u16* qp = qbase + (size_t)tq * 768;
#pragma unroll
    for (int s = 0; s < 4; ++s) qf[s] = *(const bf16x8*)(qp + 16 * s + 8 * h2);
    uint4 u1 = *(const uint4*)(qp + 64 + 8 * h2), u2 = *(const uint4*)(qp + 80 + 8 * h2);
    const float* rp = rope + (size_t)tq * 32 + 8 * h2;
    float4 c0 = *(const float4*)(rp), c1v = *(const float4*)(rp + 4), s0 = *(const float4*)(rp + 16), s1 = *(const float4*)(rp + 20);
    float cs[8] = {c0.x, c0.y, c0.z, c0.w, c1v.x, c1v.y, c1v.z, c1v.w};
    float sn[8] = {s0.x, s0.y, s0.z, s0.w, s1.x, s1.y, s1.z, s1.w};
    unsigned a1[4] = {u1.x, u1.y, u1.z, u1.w}, a2[4] = {u2.x, u2.y, u2.z, u2.w};
    unsigned r1[4], r2[4];
#pragma unroll
    for (int j = 0; j < 4; ++j) {
      float x1a = bflo(a1[j]), x1b = bfhi(a1[j]), x2a = bflo(a2[j]), x2b = bfhi(a2[j]);
      r1[j] = pk2(x1a * cs[2 * j] - x2a * sn[2 * j], x1b * cs[2 * j + 1] - x2b * sn[2 * j + 1]);
      r2[j] = pk2(x1a * sn[2 * j] + x2a * cs[2 * j], x1b * sn[2 * j + 1] + x2b * cs[2 * j + 1]);
    }
    uint4 o1 = {r1[0], r1[1], r1[2], r1[3]}, o2 = {r2[0], r2[1], r2[2], r2[3]};
    qf[4] = __builtin_bit_cast(bf16x8, o1);
    qf[5] = __builtin_bit_cast(bf16x8, o2);
  }
  f32x16 o[2];
#pragma unroll
  for (int i = 0; i < 16; ++i) { o[0][i] = 0.f; o[1][i] = 0.f; }
  float mrun = -INFINITY, lsum = 0.f;
  struct TileRegs { uint4 k0, k1, v; };
  TileRegs ra_, rb_;
  ra_.k0 = ra_.k1 = ra_.v = uint4{0, 0, 0, 0};
  rb_ = ra_;
  const int c1 = tid + 512;
  auto load_tile = [&](int t, TileRegs& r) {
    const int k0 = t * 64;
    r.k0 = *(const uint4*)(kbase + (size_t)(k0 + tid / KCH) * 96 + (tid % KCH) * 8);
    if (c1 < 64 * KCH) r.k1 = *(const uint4*)(kbase + (size_t)(k0 + c1 / KCH) * 96 + (c1 % KCH) * 8);
    r.v = *(const uint4*)(vtbase + (size_t)(tid >> 3) * SEQ + k0 + (tid & 7) * 8);
  };
  auto store_tile = [&](int stg, const TileRegs& r) {
    char* sb = smem + stg * ASTAGE;
    *(uint4*)(sb + (tid / KCH) * KROW + (tid % KCH) * 16) = r.k0;
    if (c1 < 64 * KCH) *(uint4*)(sb + (c1 / KCH) * KROW + (c1 % KCH) * 16) = r.k1;
    const int c = tid & 7;
    char* vp = sb + KBYTES + (tid >> 3) * VROW + (c >> 1) * 32 + (c & 1) * 8;
    *(uint2*)(vp) = uint2{r.v.x, r.v.y};
    *(uint2*)(vp + 16) = uint2{r.v.z, r.v.w};
  };
  auto qk = [&](const char* sb, f32x16 (&st)[2]) {
#pragma unroll
    for (int i = 0; i < 16; ++i) { st[0][i] = 0.f; st[1][i] = 0.f; }
#pragma unroll
    for (int s = 0; s < NS; ++s) {
      const bf16x8 kf0 = *(const bf16x8*)(sb + lq * KROW + s * 32 + h2 * 16);
      const bf16x8 kf1 = *(const bf16x8*)(sb + (32 + lq) * KROW + s * 32 + h2 * 16);
      st[0] = __builtin_amdgcn_mfma_f32_32x32x16_bf16(kf0, qf[s], st[0], 0, 0, 0);
      st[1] = __builtin_amdgcn_mfma_f32_32x32x16_bf16(kf1, qf[s], st[1], 0, 0, 0);
    }
  };
  auto step = [&](int t, f32x16 (&st_c)[2], f32x16 (&st_n)[2]) {
    load_tile(t + 3 < NT_ ? t + 3 : NT_ - 1, rb_);
    __builtin_amdgcn_sched_barrier(0);
    const char* sb = smem + (t % 3) * ASTAGE;
    const char* sbn = smem + ((t + 1) % 3) * ASTAGE;
    float mx = -INFINITY;
#pragma unroll
    for (int kt2 = 0; kt2 < 2; ++kt2)
#pragma unroll
      for (int r = 0; r < 16; ++r) mx = fmaxf(mx, st_c[kt2][r]);
    mx *= scale2;
    mx = fmaxf(mx, __shfl_xor(mx, 32, 64));
    if (__builtin_amdgcn_ballot_w64(mx > mrun + 8.f) != 0ull) {
      asm volatile("" ::: "memory");
      const float mnew = fmaxf(mrun, mx);
      const float alpha = fexp2(mrun - mnew);
      mrun = mnew;
      lsum *= alpha;
#pragma unroll
      for (int i = 0; i < 16; ++i) { o[0][i] *= alpha; o[1][i] *= alpha; }
    }
    qk(sbn, st_n);
    float ps = 0.f;
#pragma unroll
    for (int kt2 = 0; kt2 < 2; ++kt2)
#pragma unroll
      for (int r = 0; r < 16; ++r) {
        const float p = fexp2(__builtin_fmaf(st_c[kt2][r], scale2, -mrun));
        st_c[kt2][r] = p;
        ps += p;
      }
    lsum += ps;
#pragma unroll
    for (int kt2 = 0; kt2 < 2; ++kt2)
#pragma unroll
      for (int sp = 0; sp < 2; ++sp) {
        uint4 pu;
        pu.x = pk2(st_c[kt2][8 * sp + 0], st_c[kt2][8 * sp + 1]);
        pu.y = pk2(st_c[kt2][8 * sp + 2], st_c[kt2][8 * sp + 3]);
        pu.z = pk2(st_c[kt2][8 * sp + 4], st_c[kt2][8 * sp + 5]);
        pu.w = pk2(st_c[kt2][8 * sp + 6], st_c[kt2][8 * sp + 7]);
        const bf16x8 pf = __builtin_bit_cast(bf16x8, pu);
#pragma unroll
        for (int dt = 0; dt < 2; ++dt) {
          const bf16x8 vf = *(const bf16x8*)(sb + KBYTES + (dt * 32 + lq) * VROW + (kt2 * 2 + sp) * 32 + h2 * 16);
          o[dt] = __builtin_amdgcn_mfma_f32_32x32x16_bf16(vf, pf, o[dt], 0, 0, 0);
        }
      }
    __builtin_amdgcn_sched_barrier(0);
    store_tile((t + 2) % 3, ra_);
    __syncthreads();
    ra_ = rb_;
  };
  load_tile(0, ra_);
  load_tile(1, rb_);
  store_tile(0, ra_);
  store_tile(1, rb_);
  load_tile(2, ra_);
  __syncthreads();
  f32x16 sa[2], sb2[2];
  qk(smem, sa);
  for (int t = 0; t < NT_; t += 2) {
    step(t, sa, sb2);
    step(t + 1, sb2, sa);
  }
  const float ltot = lsum + __shfl_xor(lsum, 32, 64);
  const float inv = 1.f / ltot;
  u16* op = obase + (size_t)tq * 512;
#pragma unroll
  for (int dt = 0; dt < 2; ++dt)
#pragma unroll
    for (int g = 0; g < 4; ++g) {
      uint2 u;
      u.x = pk2(o[dt][4 * g + 0] * inv, o[dt][4 * g + 1] * inv);
      u.y = pk2(o[dt][4 * g + 2] * inv, o[dt][4 * g + 3] * inv);
      *(uint2*)(op + dt * 32 + 8 * g + 4 * h2) = u;
    }
}

DI void mla_item_q64(const u16* __restrict__ qbase, const u16* __restrict__ kbase, const u16* __restrict__ vtbase, u16* __restrict__ obase,
                     const float* __restrict__ rope, int q0, float scale2, char* smem) {
  constexpr int NS = 6, KROW = 208, KCH = 12, KBYTES = 64 * KROW, VROW = 144, VBYTES = 64 * VROW, ASTAGE = KBYTES + VBYTES;
  constexpr int NT_ = SEQ / 64;
  const int tid = otid(), lane = tid & 63, wave = tid >> 6;
  const int lq = lane & 31, h2 = lane >> 5;
  const int tqA = q0 + wave * 64 + lq, tqB = tqA + 32;
  auto load_q = [&](int tq, bf16x8 (&qf)[NS]) {
    const u16* qp = qbase + (size_t)tq * 768;
#pragma unroll
    for (int s = 0; s < 4; ++s) {
      const uint4 u = *(const uint4*)(qp + 16 * s + 8 * h2);
      uint4 w;
      w.x = pk2(bflo(u.x) * scale2, bfhi(u.x) * scale2); w.y = pk2(bflo(u.y) * scale2, bfhi(u.y) * scale2);
      w.z = pk2(bflo(u.z) * scale2, bfhi(u.z) * scale2); w.w = pk2(bflo(u.w) * scale2, bfhi(u.w) * scale2);
      qf[s] = __builtin_bit_cast(bf16x8, w);
    }
    uint4 u1 = *(const uint4*)(qp + 64 + 8 * h2), u2 = *(const uint4*)(qp + 80 + 8 * h2);
    const float* rp = rope + (size_t)tq * 32 + 8 * h2;
    float4 c0 = *(const float4*)(rp), c1v = *(const float4*)(rp + 4), s0 = *(const float4*)(rp + 16), s1 = *(const float4*)(rp + 20);
    float cs[8] = {c0.x, c0.y, c0.z, c0.w, c1v.x, c1v.y, c1v.z, c1v.w};
    float sn[8] = {s0.x, s0.y, s0.z, s0.w, s1.x, s1.y, s1.z, s1.w};
    unsigned a1[4] = {u1.x, u1.y, u1.z, u1.w}, a2[4] = {u2.x, u2.y, u2.z, u2.w};
    unsigned r1[4], r2[4];
#pragma unroll
    for (int j = 0; j < 4; ++j) {
      float x1a = bflo(a1[j]), x1b = bfhi(a1[j]), x2a = bflo(a2[j]), x2b = bfhi(a2[j]);
      r1[j] = pk2((x1a * cs[2 * j] - x2a * sn[2 * j]) * scale2, (x1b * cs[2 * j + 1] - x2b * sn[2 * j + 1]) * scale2);
      r2[j] = pk2((x1a * sn[2 * j] + x2a * cs[2 * j]) * scale2, (x1b * sn[2 * j + 1] + x2b * cs[2 * j + 1]) * scale2);
    }
    uint4 o1 = {r1[0], r1[1], r1[2], r1[3]}, o2 = {r2[0], r2[1], r2[2], r2[3]};
    qf[4] = __builtin_bit_cast(bf16x8, o1);
    qf[5] = __builtin_bit_cast(bf16x8, o2);
  };
  bf16x8 qfA[NS], qfB[NS];
  load_q(tqA, qfA);
  load_q(tqB, qfB);
  f32x16 oA[2], oB[2];
#pragma unroll
  for (int i = 0; i < 16; ++i) { oA[0][i] = 0.f; oA[1][i] = 0.f; oB[0][i] = 0.f; oB[1][i] = 0.f; }
  float mA = 0.f, mB = 0.f, lA = 0.f, lB = 0.f;
  const int c1 = tid + 512;
  const bool has1 = c1 < 64 * KCH;
  const u16* kp0 = kbase + (size_t)(tid / KCH) * 96 + (tid % KCH) * 8;
  const u16* kp1 = kbase + (size_t)((has1 ? c1 : tid) / KCH) * 96 + ((has1 ? c1 : tid) % KCH) * 8;
  const u16* vp0 = vtbase + (size_t)(tid >> 3) * SEQ + (tid & 7) * 8;
  const int ks0 = (tid / KCH) * KROW + (tid % KCH) * 16, ks1 = ((has1 ? c1 : tid) / KCH) * KROW + ((has1 ? c1 : tid) % KCH) * 16;
  const int vs0 = KBYTES + (tid >> 3) * VROW + ((tid & 7) >> 1) * 32 + (tid & 1) * 8;
  uint4 rk0, rk1, rv;
#define Q_LOAD(t_)                                              \
  do {                                                          \
    const size_t ko_ = (size_t)(t_) * 64 * 96;                  \
    rk0 = *(const uint4*)(kp0 + ko_);                           \
    rk1 = *(const uint4*)(kp1 + ko_);                           \
    rv = *(const uint4*)(vp0 + (t_) * 64);                      \
  } while (0)
#define Q_STORE(stg_)                                           \
  do {                                                          \
    char* sb_ = smem + (stg_) * ASTAGE;                         \
    *(uint4*)(sb_ + ks0) = rk0;                                 \
    if (has1) *(uint4*)(sb_ + ks1) = rk1;                       \
    *(uint2*)(sb_ + vs0) = uint2{rv.x, rv.y};                   \
    *(uint2*)(sb_ + vs0 + 16) = uint2{rv.z, rv.w};              \
  } while (0)
  auto softmax = [&](f32x16 (&st)[2], float& mrun, float& lsum, f32x16 (&o)[2], bf16x8 (&pf)[2][2], bool first) {
    float mx = -INFINITY;
#pragma unroll
    for (int kt2 = 0; kt2 < 2; ++kt2)
#pragma unroll
      for (int r = 0; r < 16; ++r) mx = fmaxf(mx, st[kt2][r]);
    mx = fmaxf(mx, __shfl_xor(mx, 32, 64));
    if (first || __builtin_amdgcn_ballot_w64(mx > 8.f) != 0ull) {
      asm volatile("" ::: "memory");
      const float delta = first ? mx : fmaxf(mx, 0.f);
      mrun += delta;
      if (!first) {
        const float alpha = fexp2(-delta);
        lsum *= alpha;
#pragma unroll
        for (int i = 0; i < 16; ++i) { o[0][i] *= alpha; o[1][i] *= alpha; }
      }
#pragma unroll
      for (int i = 0; i < 16; ++i) { st[0][i] -= delta; st[1][i] -= delta; }
    }
    float ps = 0.f;
#pragma unroll
    for (int kt2 = 0; kt2 < 2; ++kt2) {
#pragma unroll
      for (int r = 0; r < 16; ++r) {
        const float p = fexp2(st[kt2][r]);
        st[kt2][r] = p;
        ps += p;
      }
#pragma unroll
      for (int sp = 0; sp < 2; ++sp) {
        uint4 pu;
        pu.x = pk2(st[kt2][8 * sp + 0], st[kt2][8 * sp + 1]);
        pu.y = pk2(st[kt2][8 * sp + 2], st[kt2][8 * sp + 3]);
        pu.z = pk2(st[kt2][8 * sp + 4], st[kt2][8 * sp + 5]);
        pu.w = pk2(st[kt2][8 * sp + 6], st[kt2][8 * sp + 7]);
        pf[kt2][sp] = __builtin_bit_cast(bf16x8, pu);
      }
    }
    lsum += ps;
  };
  Q_LOAD(0);
  Q_STORE(0);
  __syncthreads();
  for (int t = 0; t < NT_; ++t) {
    { const int tn = t + 1 < NT_ ? t + 1 : t; Q_LOAD(tn); }
    __builtin_amdgcn_sched_barrier(0);
    const char* sb = smem + (t & 1) * ASTAGE;
    bf16x8 pA[2][2], pB[2][2];
    {
      f32x16 stA[2], stB[2];
      {
        f32x16 nA, nB;
#pragma unroll
        for (int i = 0; i < 16; ++i) { nA[i] = -mA; nB[i] = -mB; }
        const bf16x8 kf0 = *(const bf16x8*)(sb + lq * KROW + h2 * 16);
        const bf16x8 kf1 = *(const bf16x8*)(sb + (32 + lq) * KROW + h2 * 16);
        stA[0] = __builtin_amdgcn_mfma_f32_32x32x16_bf16(kf0, qfA[0], nA, 0, 0, 0);
        stB[0] = __builtin_amdgcn_mfma_f32_32x32x16_bf16(kf0, qfB[0], nB, 0, 0, 0);
        stA[1] = __builtin_amdgcn_mfma_f32_32x32x16_bf16(kf1, qfA[0], nA, 0, 0, 0);
        stB[1] = __builtin_amdgcn_mfma_f32_32x32x16_bf16(kf1, qfB[0], nB, 0, 0, 0);
      }
#pragma unroll
      for (int s = 1; s < NS; ++s) {
        const bf16x8 kf0 = *(const bf16x8*)(sb + lq * KROW + s * 32 + h2 * 16);
        const bf16x8 kf1 = *(const bf16x8*)(sb + (32 + lq) * KROW + s * 32 + h2 * 16);
        stA[0] = __builtin_amdgcn_mfma_f32_32x32x16_bf16(kf0, qfA[s], stA[0], 0, 0, 0);
        stB[0] = __builtin_amdgcn_mfma_f32_32x32x16_bf16(kf0, qfB[s], stB[0], 0, 0, 0);
        stA[1] = __builtin_amdgcn_mfma_f32_32x32x16_bf16(kf1, qfA[s], stA[1], 0, 0, 0);
        stB[1] = __builtin_amdgcn_mfma_f32_32x32x16_bf16(kf1, qfB[s], stB[1], 0, 0, 0);
      }
      softmax(stA, mA, lA, oA, pA, t == 0);
      softmax(stB, mB, lB, oB, pB, t == 0);
    }
#pragma unroll
    for (int kt2 = 0; kt2 < 2; ++kt2)
#pragma unroll
      for (int sp = 0; sp < 2; ++sp)
#pragma unroll
        for (int dt = 0; dt < 2; ++dt) {
          const bf16x8 vf = *(const bf16x8*)(sb + KBYTES + (dt * 32 + lq) * VROW + (kt2 * 2 + sp) * 32 + h2 * 16);
          oA[dt] = __builtin_amdgcn_mfma_f32_32x32x16_bf16(vf, pA[kt2][sp], oA[dt], 0, 0, 0);
          oB[dt] = __builtin_amdgcn_mfma_f32_32x32x16_bf16(vf, pB[kt2][sp], oB[dt], 0, 0, 0);
        }
    __builtin_amdgcn_sched_barrier(0);
    Q_STORE((t + 1) & 1);
    __syncthreads();
  }
#undef Q_LOAD
#undef Q_STORE
  {
    const float inv = 1.f / (lA + __shfl_xor(lA, 32, 64));
    u16* op = obase + (size_t)tqA * 512;
#pragma unroll
    for (int dt = 0; dt < 2; ++dt)
#pragma unroll
      for (int g = 0; g < 4; ++g) {
        uint2 u;
        u.x = pk2(oA[dt][4 * g + 0] * inv, oA[dt][4 * g + 1] * inv);
        u.y = pk2(oA[dt][4 * g + 2] * inv, oA[dt][4 * g + 3] * inv);
        *(uint2*)(op + dt * 32 + 8 * g + 4 * h2) = u;
      }
  }
  {
    const float inv = 1.f / (lB + __shfl_xor(lB, 32, 64));
    u16* op = obase + (size_t)tqB * 512;
#pragma unroll
    for (int dt = 0; dt < 2; ++dt)
#pragma unroll
      for (int g = 0; g < 4; ++g) {
        uint2 u;
        u.x = pk2(oB[dt][4 * g + 0] * inv, oB[dt][4 * g + 1] * inv);
        u.y = pk2(oB[dt][4 * g + 2] * inv, oB[dt][4 * g + 3] * inv);
        *(uint2*)(op + dt * 32 + 8 * g + 4 * h2) = u;
      }
  }
}

DI void gqa_item_pair(const u16* __restrict__ qbA, const u16* __restrict__ kbase, const u16* __restrict__ vtbase, u16* __restrict__ obA,
                      const int* __restrict__ posb, int q0, float scale2, float slopeA, float slopeB, float sinkA, float sinkB, char* smem) {
  constexpr int NS = 4, KROW = 144, KBYTES = 64 * KROW, VROW = 144, VBYTES = 64 * VROW, ASTAGE = KBYTES + VBYTES + 256;
  const int tid = otid(), lane = tid & 63, wave = tid >> 6;
  const int lq = lane & 31, h2 = lane >> 5;
  const int wq0 = q0 + wave * 32;
  const int tq = wq0 + lq;
  bf16x8 qfA[NS], qfB[NS];
  {
    const u16* qp = qbA + (size_t)tq * ZS;
#pragma unroll
    for (int s = 0; s < NS; ++s) { qfA[s] = *(const bf16x8*)(qp + 16 * s + 8 * h2); qfB[s] = *(const bf16x8*)(qp + 64 + 16 * s + 8 * h2); }
  }
  const float posqf = (float)posb[tq];
  f32x16 oA[2], oB[2];
#pragma unroll
  for (int i = 0; i < 16; ++i) { oA[0][i] = 0.f; oA[1][i] = 0.f; oB[0][i] = 0.f; oB[1][i] = 0.f; }
  float mA = sinkA, mB = sinkB, lA = 0.f, lB = 0.f;
  const int kstart = q0 - 128;
  uint4 rk, rv;
  int rp_ = 0;
  auto load_tile = [&](int t) {
    const int k0 = kstart + t * 64;
    if ((k0 >= 0) && (k0 < SEQ)) {
      rk = *(const uint4*)(kbase + (size_t)(k0 + (tid >> 3)) * ZS + (tid & 7) * 8);
      rv = *(const uint4*)(vtbase + (size_t)(tid >> 3) * SEQ + k0 + (tid & 7) * 8);
      if (tid < 64) rp_ = posb[k0 + tid];
    } else {
      rk = rv = uint4{0, 0, 0, 0};
      rp_ = 0;
    }
  };
  auto store_tile = [&](int stg) {
    char* sb = smem + stg * ASTAGE;
    *(uint4*)(sb + (tid >> 3) * KROW + (tid & 7) * 16) = rk;
    const int c = tid & 7;
    char* vp = sb + KBYTES + (tid >> 3) * VROW + (c >> 1) * 32 + (c & 1) * 8;
    *(uint2*)(vp) = uint2{rv.x, rv.y};
    *(uint2*)(vp + 16) = uint2{rv.z, rv.w};
    if (tid < 64) *(int*)(sb + KBYTES + VBYTES + tid * 4) = rp_;
  };
  auto softmax = [&](f32x16 (&st)[2], float& mrun, float& lsum, f32x16 (&o)[2], bf16x8 (&pf)[2][2]) {
    float mx = -INFINITY;
#pragma unroll
    for (int kt2 = 0; kt2 < 2; ++kt2)
#pragma unroll
      for (int r = 0; r < 16; ++r) mx = fmaxf(mx, st[kt2][r]);
    mx = fmaxf(mx, __shfl_xor(mx, 32, 64));
    if (__builtin_amdgcn_ballot_w64(mx > mrun + 8.f) != 0ull) {
      asm volatile("" ::: "memory");
      const float mnew = fmaxf(mrun, mx);
      const float alpha = fexp2(mrun - mnew);
      mrun = mnew;
      lsum *= alpha;
#pragma unroll
      for (int i = 0; i < 16; ++i) { o[0][i] *= alpha; o[1][i] *= alpha; }
    }
    float ps = 0.f;
#pragma unroll
    for (int kt2 = 0; kt2 < 2; ++kt2) {
#pragma unroll
      for (int r = 0; r < 16; ++r) {
        const float p = fexp2(st[kt2][r] - mrun);
        st[kt2][r] = p;
        ps += p;
      }
#pragma unroll
      for (int sp = 0; sp < 2; ++sp) {
        uint4 pu;
        pu.x = pk2(st[kt2][8 * sp + 0], st[kt2][8 * sp + 1]);
        pu.y = pk2(st[kt2][8 * sp + 2], st[kt2][8 * sp + 3]);
        pu.z = pk2(st[kt2][8 * sp + 4], st[kt2][8 * sp + 5]);
        pu.w = pk2(st[kt2][8 * sp + 6], st[kt2][8 * sp + 7]);
        pf[kt2][sp] = __builtin_bit_cast(bf16x8, pu);
      }
    }
    lsum += ps;
  };
  load_tile(0);
  store_tile(0);
  __syncthreads();
  for (int t = 0; t < 8; ++t) {
    load_tile(t + 1 < 8 ? t + 1 : t);
    __builtin_amdgcn_sched_barrier(0);
    const int k0 = kstart + t * 64;
    const bool active = (k0 >= 0) && (k0 < SEQ) && (k0 + 63 >= wq0 - 128) && (k0 <= wq0 + 31 + 128);
    if (active) {
      const char* sb = smem + (t & 1) * ASTAGE;
      bf16x8 pA[2][2], pB[2][2];
      {
        f32x16 stA[2], stB[2];
#pragma unroll
        for (int i = 0; i < 16; ++i) { stA[0][i] = 0.f; stA[1][i] = 0.f; stB[0][i] = 0.f; stB[1][i] = 0.f; }
#pragma unroll
        for (int s = 0; s < NS; ++s) {
          const bf16x8 kf0 = *(const bf16x8*)(sb + lq * KROW + s * 32 + h2 * 16);
          const bf16x8 kf1 = *(const bf16x8*)(sb + (32 + lq) * KROW + s * 32 + h2 * 16);
          stA[0] = __builtin_amdgcn_mfma_f32_32x32x16_bf16(kf0, qfA[s], stA[0], 0, 0, 0);
          stB[0] = __builtin_amdgcn_mfma_f32_32x32x16_bf16(kf0, qfB[s], stB[0], 0, 0, 0);
          stA[1] = __builtin_amdgcn_mfma_f32_32x32x16_bf16(kf1, qfA[s], stA[1], 0, 0, 0);
          stB[1] = __builtin_amdgcn_mfma_f32_32x32x16_bf16(kf1, qfB[s], stB[1], 0, 0, 0);
        }
        const float tqk = (float)(tq - k0 - 4 * h2);
#pragma unroll
        for (int kt2 = 0; kt2 < 2; ++kt2)
#pragma unroll
          for (int g4 = 0; g4 < 4; ++g4) {
            const int4 pk4i = *(const int4*)(sb + KBYTES + VBYTES + (kt2 * 32 + 8 * g4 + 4 * h2) * 4);
            const float pkf[4] = {(float)pk4i.x, (float)pk4i.y, (float)pk4i.z, (float)pk4i.w};
#pragma unroll
            for (int j = 0; j < 4; ++j) {
              const int r = g4 * 4 + j;
              const float dist = __builtin_fabsf(posqf - pkf[j]);
              const bool inb = __builtin_fabsf(tqk - (float)(kt2 * 32 + 8 * g4 + j)) <= 128.f;
              const float va = __builtin_fmaf(-slopeA, dist, stA[kt2][r] * scale2);
              const float vb = __builtin_fmaf(-slopeB, dist, stB[kt2][r] * scale2);
              stA[kt2][r] = inb ? va : -INFINITY;
              stB[kt2][r] = inb ? vb : -INFINITY;
            }
          }
        softmax(stA, mA, lA, oA, pA);
        softmax(stB, mB, lB, oB, pB);
      }
#pragma unroll
      for (int kt2 = 0; kt2 < 2; ++kt2)
#pragma unroll
        for (int sp = 0; sp < 2; ++sp)
#pragma unroll
          for (int dt = 0; dt < 2; ++dt) {
            const bf16x8 vf = *(const bf16x8*)(sb + KBYTES + (dt * 32 + lq) * VROW + (kt2 * 2 + sp) * 32 + h2 * 16);
            oA[dt] = __builtin_amdgcn_mfma_f32_32x32x16_bf16(vf, pA[kt2][sp], oA[dt], 0, 0, 0);
            oB[dt] = __builtin_amdgcn_mfma_f32_32x32x16_bf16(vf, pB[kt2][sp], oB[dt], 0, 0, 0);
          }
    }
    __builtin_amdgcn_sched_barrier(0);
    store_tile((t + 1) & 1);
    __syncthreads();
  }
  {
    const float inv = 1.f / (lA + __shfl_xor(lA, 32, 64) + fexp2(sinkA - mA));
    u16* op = obA + (size_t)tq * 512;
#pragma unroll
    for (int dt = 0; dt < 2; ++dt)
#pragma unroll
      for (int g = 0; g < 4; ++g) {
        uint2 u;
        u.x = pk2(oA[dt][4 * g + 0] * inv, oA[dt][4 * g + 1] * inv);
        u.y = pk2(oA[dt][4 * g + 2] * inv, oA[dt][4 * g + 3] * inv);
        *(uint2*)(op + dt * 32 + 8 * g + 4 * h2) = u;
      }
  }
  {
    const float inv = 1.f / (lB + __shfl_xor(lB, 32, 64) + fexp2(sinkB - mB));
    u16* op = obA + (size_t)tq * 512 + 64;
#pragma unroll
    for (int dt = 0; dt < 2; ++dt)
#pragma unroll
      for (int g = 0; g < 4; ++g) {
        uint2 u;
        u.x = pk2(oB[dt][4 * g + 0] * inv, oB[dt][4 * g + 1] * inv);
        u.y = pk2(oB[dt][4 * g + 2] * inv, oB[dt][4 * g + 3] * inv);
        *(uint2*)(op + dt * 32 + 8 * g + 4 * h2) = u;
      }
  }
}

#define XB_XCNT(j) (64 * (j))
#define XB_XSUB(j) (1024 + 64 * (j))
#define XB_XGEN(j) (2048 + 64 * (j))
#define XB_TOP 3072
#define XB_TOPGEN 3136
#define XB_WORDS 3200
DI unsigned xb_ld(unsigned* p) { return __hip_atomic_load(p, __ATOMIC_RELAXED, __HIP_MEMORY_SCOPE_AGENT); }
DI unsigned xb_add(unsigned* p, unsigned v) { return __hip_atomic_fetch_add(p, v, __ATOMIC_RELAXED, __HIP_MEMORY_SCOPE_AGENT); }
struct GBar { unsigned* bar; const int* ctl; };
#define XB_SPIN(cond) do { unsigned sp_ = 0; while (cond) { __builtin_amdgcn_s_sleep(1); if (++sp_ > (1u << 22)) break; } } while (0)
DI void gbar_sync(const GBar& b) {
  asm volatile("s_waitcnt vmcnt(0)" ::: "memory");
  __syncthreads();
  if (threadIdx.x == 0) {
    unsigned* bar = b.bar;
    __builtin_amdgcn_s_waitcnt(0);
    const unsigned bx = (unsigned)b.ctl[1], nloc = (unsigned)b.ctl[2], nx = (unsigned)b.ctl[3];
    const unsigned old = xb_add(&bar[XB_XSUB(bx)], 1u);
    const unsigned gen = old / nloc;
    if (old + 1u == (gen + 1u) * nloc) {
      __builtin_amdgcn_fence(__ATOMIC_RELEASE, "agent");
      asm volatile("s_waitcnt vmcnt(0)" ::: "memory");
      const unsigned og = xb_add(&bar[XB_TOP], 1u);
      const unsigned tg = og / nx;
      if (og + 1u == (tg + 1u) * nx) xb_add(&bar[XB_TOPGEN], 1u);
      else XB_SPIN(xb_ld(&bar[XB_TOPGEN]) == tg);
      __builtin_amdgcn_fence(__ATOMIC_ACQUIRE, "agent");
      xb_add(&bar[XB_XGEN(bx)], 1u);
      asm volatile("s_waitcnt vmcnt(0)" ::: "memory");
    } else {
      XB_SPIN(xb_ld(&bar[XB_XGEN(bx)]) == gen);
      __builtin_amdgcn_fence(__ATOMIC_ACQUIRE, "agent");
      asm volatile("s_waitcnt vmcnt(0)" ::: "memory");
    }
  }
  __syncthreads();
}

__global__ void __launch_bounds__(NTHR) mega(Params p) {
  extern __shared__ __attribute__((aligned(16))) char smem[];
  const int bid = blockIdx.x, nblk = gridDim.x;
  unsigned char* ws = p.ws;
  u16* Wall = (u16*)(ws + OFF_W);
  u16* E1 = (u16*)(ws + OFF_E1);
  u16* E2 = (u16*)(ws + OFF_E2);
  u16* E3 = (u16*)(ws + OFF_E3);
  float* ropetab = (float*)(ws + OFF_ROPE);
  u16* pb = (u16*)(ws + OFF_PB);
  u16* hbuf = (u16*)(ws + OFF_H);
  u16* oa = (u16*)(ws + OFF_OA);
  u16* oc = (u16*)(ws + OFF_OC);
  u16* zs = (u16*)(ws + R_ZS);
  u16* qm = (u16*)(ws + R_QM);
  u16* kfull = (u16*)(ws + R_KF);
  u16* vt = (u16*)(ws + R_VT);
  u16* vtc = (u16*)(ws + R_VTC);
  u16* yt = (u16*)(ws + R_YT);
  u16* tp = (u16*)(ws + R_TP);
  u16* ob = (u16*)(ws + R_OB);
  u16* merged = (u16*)(ws + OFF_H);
  u16* gbuf = (u16*)(ws + R_GATE);
  u16* ybuf = (u16*)(ws + R_Y);
  u16* hid = (u16*)(ws + R_HID);
  u16* ff = (u16*)(ws + R_FF);
  u16* ebuf = (u16*)(ws + R_E);
  float* xout = p.out;
  u16* x16 = (u16*)((char*)p.out + 64 * MiB);
  float* aux = (float*)(smem + LDS_AUX);

  int rank;
  GBar gb;
  {
    unsigned* bar = (unsigned*)(ws + OFF_CNT);
    int* auxi = (int*)(smem + LDS_CTL);
    const int t0 = otid();
    unsigned xcc = 0, slot = 0;
    if (t0 == 0) {
      xcc = (unsigned)__builtin_amdgcn_s_getreg((3 << 11) | 20) & 0xFu;
      slot = xb_add(&bar[XB_XCNT(xcc)], 1u);
    }
    if (p.ph_hi < 0) cg::this_grid().sync();
    if (t0 == 0) {
      unsigned r = slot, nloc = 1, nx = 0, spins = 0;
      for (;;) {
        unsigned sum = 0;
        r = slot; nloc = 1; nx = 0;
        for (unsigned x = 0; x < 16; ++x) {
          const unsigned c = xb_ld(&bar[XB_XCNT(x)]);
          sum += c;
          if (x < xcc) r += c;
          if (x == xcc) nloc = c;
          nx += (c > 0u) ? 1u : 0u;
        }
        if (sum == (unsigned)nblk || ++spins > (1u << 20)) break;
        __builtin_amdgcn_s_sleep(1);
      }
      auxi[0] = (int)r; auxi[1] = (int)xcc; auxi[2] = (int)(nloc ? nloc : 1u); auxi[3] = (int)(nx ? nx : 1u);
    }
    __syncthreads();
    rank = __builtin_amdgcn_readfirstlane(auxi[0]);
    gb.bar = bar;
    gb.ctl = auxi;
  }
  for (int ph = p.ph_lo; ph < p.ph_hi; ++ph) {
    if (ph > p.ph_lo) gbar_sync(gb);
    if (ph == 0) {
      const int tid = otid(), wave = tid >> 6;
      for (int it0 = bid; it0 < 2 * WT_ITEMS_LAYER; it0 += nblk) {
        const int layer = it0 / WT_ITEMS_LAYER;
        int it = it0 % WT_ITEMS_LAYER;
        const float* src = nullptr; const float* gain = nullptr; int K = 0, N = 0, mode = 0; size_t doff = 0; bool found = false;
#define WSEL(cnt, IDX, KK, NN, DOFF, G, MODE)                                                             \
  if (!found) {                                                                                           \
    if (it < (cnt)) { src = p.in[IDX] + (size_t)layer * (KK) * (NN); K = (KK); N = (NN); doff = (DOFF); gain = (G); mode = (MODE); found = true; } \
    else it -= (cnt);                                                                                     \
  }
        WSEL(1104, 4, 1024, INC, W_IN, nullptr, 0)
        WSEL(72, 6, 384, 768, W_UQ, p.in[5] + layer * 384, 0)
        WSEL(32, 8, 128, 1024, W_UKV, p.in[7] + layer * 128, 0)
        WSEL(128, 10, 512, 1024, W_A, nullptr, 0)
        WSEL(256, 11, 1024, 1024, W_B, nullptr, 0)
        WSEL(128, 12, 512, 1024, W_C, nullptr, 0)
        WSEL(256, 13, 1024, 1024, W_OUT, nullptr, 0)
        WSEL(704, 16, 1024, FFN, W_FG, nullptr, 1)
        WSEL(704, 17, 1024, FFN, W_FG, nullptr, 2)
        WSEL(704, 18, FFN, 1024, W_FD, nullptr, 0)
        WSEL(64, 20, 256, 1024, W_PLE, nullptr, 0)
        WSEL(256, 21, 1024, 1024, W_PG, nullptr, 0)
#undef WSEL
        wt_tile(src, K, N, Wall + (size_t)layer * W_LAYER + doff, gain, it, mode, smem);
      }
      for (int it = bid; it < NTOK * 16 / NTHR; it += nblk) {
        const int e = it * NTHR + tid;
        const int tok = e >> 4, i = e & 15;
        const float invf = powf(10000.f, -(float)i / 16.f);
        const float ang = (float)p.pos[tok] * invf;
        double r = (double)ang * 0.15915494309189535;
        r -= floor(r);
        const float rf = (float)r;
        ropetab[(size_t)tok * 32 + i] = cos_rev(rf);
        ropetab[(size_t)tok * 32 + 16 + i] = sin_rev(rf);
      }
      for (int it = bid; it < (131072 + 65536 + 1048576) / NTHR; it += nblk) {
        int e = it * NTHR + tid;
        if (e < 131072) {
          const int n = e >> 8, c = e & 255, comp = n >> 8, cp = n & 255;
          const float r = (float)((c * cp) & 255) * (1.f / 256.f);
          E1[e] = f2bf((comp ? -sin_rev(r) : cos_rev(r)) * (1.f / 16.f));
        } else if (e < 131072 + 65536) {
          e -= 131072;
          const int n = e >> 8, k = e & 255, comp = n >> 7, k1 = n & 127, part = k >> 7, n1 = k & 127;
          const float r = (float)((k1 * n1) & 127) * (1.f / 128.f);
          const float cc = cos_rev(r), ss = sin_rev(r);
          float v = comp == 0 ? (part == 0 ? cc : ss) : (part == 0 ? -ss : cc);
          E2[e] = f2bf(v * 0.08838834764831845f);
        } else {
          e -= 131072 + 65536;
          const int k1 = e >> 13, row = (e >> 7) & 63, k = e & 127, part = k >> 6, n2 = k & 63;
          const int kk = k1 + 128 * row;
          const float r = (float)((n2 * kk) & 8191) * (1.f / 8192.f);
          E3[e] = f2bf((part == 0 ? cos_rev(r) : sin_rev(r)) * 0.125f);
        }
      }
      for (int it = bid; it < 2 * NTOK * PLE / (NTHR * 8); it += nblk) {
        const size_t e = ((size_t)it * NTHR + tid) * 8;
        float4 a = *(const float4*)(p.in[1] + e), b = *(const float4*)(p.in[1] + e + 4);
        uint4 o = {pk2(a.x, a.y), pk2(a.z, a.w), pk2(b.x, b.y), pk2(b.z, b.w)};
        *(uint4*)(pb + e) = o;
      }
      for (int it = bid; it < NTOK / 8; it += nblk) rowpass(it * 8 + wave, p.in[0], nullptr, nullptr, nullptr, nullptr, x16, p.in[3], hbuf);
      continue;
    }
    const int layer = (ph - 1) / 15;
    const int sub = (ph - 1) % 15;
    const u16* W = Wall + (size_t)layer * W_LAYER;
    if (sub == 0) {
      {
        pg8::Order<8> S{6, 128 * 6, nblk, rank};
        pg8::gemm_phase((PG8_LAS unsigned char*)smem, pg8::Gemm{hbuf, W + W_IN, DM, 1024, 1024}, S, pg8::EpiZs{zs, vtc});
      }
    } else if (sub == 1) {
      for (int v = rank; v < 128 * 6 + 128 * 8 + 512; v += nblk) {
        const int it = v;
        const int tid = otid();
        if (it < 128 * 14) {
          const bool isq = it < 128 * 6;
          const int t2 = isq ? it : it - 128 * 6;
          const int nn = isq ? 6 : 8;
          int pm, pn; tile_of<4>(t2, nn, pm, pn);
          const int m0 = pm * 256, n0 = pn * 128;
          const int coff = isq ? 0 : 384, kd = isq ? 384 : 128;
          {
            const int row = tid >> 1, half = tid & 1;
            const u16* rp = zs + (size_t)(m0 + row) * ZS + coff + half * (kd >> 1);
            float ss = 0.f;
            for (int c = 0; c < (kd >> 4); ++c) {
              uint4 u = *(const uint4*)(rp + c * 8);
              float a;
              a = bflo(u.x); ss += a * a; a = bfhi(u.x); ss += a * a; a = bflo(u.y); ss += a * a; a = bfhi(u.y); ss += a * a;
              a = bflo(u.z); ss += a * a; a = bfhi(u.z); ss += a * a; a = bflo(u.w); ss += a * a; a = bfhi(u.w); ss += a * a;
            }
            ss += __shfl_xor(ss, 1, 64);
            if (half == 0) aux[row] = rsqrtf(ss / (float)kd + EPS);
          }
          __syncthreads();
          f32x4 acc[4][4];
          zero_acc<4, 4>(acc);
          if (isq) {
            gemm_main<4, 4, true>(acc, RowLin{zs, ZS}, m0, W + W_UQ, 384, n0, 384, smem);
            gemm_epi<4, 4, true>(acc, m0, n0, [&](int m, int n, f32x4 v, int, int) {
              const float rs = aux[m - m0];
              *(uint2*)(qm + (size_t)m * 768 + n) = pk4(v * rs);
            });
          } else {
            gemm_main<4, 4, true>(acc, RowLin{zs + 384, ZS}, m0, W + W_UKV, 128, n0, 128, smem);
            gemm_epi<4, 4, true>(acc, m0, n0, [&](int m, int n, f32x4 v, int, int) {
              const float rs = aux[m - m0];
              const int hd = n >> 7, w = n & 127, b = m >> 13, s = m & 8191;
              if (w < 64) {
                *(uint2*)(kfull + ((size_t)(b * 8 + hd) * SEQ + s) * 96 + w) = pk4(v * rs);
              } else {
                u16* q = vt + ((size_t)(b * 8 + hd) * 64 + (w - 64)) * SEQ + s;
                q[0] = f2bf(v[0] * rs); q[SEQ] = f2bf(v[1] * rs); q[2 * SEQ] = f2bf(v[2] * rs); q[3 * SEQ] = f2bf(v[3] * rs);
              }
            });
          }
          __syncthreads();
        } else {
          const int e = (it - 128 * 14) * NTHR + tid;
          const int tok = e >> 3, hd = e & 7, b = tok >> 13, s = tok & 8191;
          const u16* kr = zs + (size_t)tok * ZS + 512;
          const float* rp = ropetab + (size_t)tok * 32;
          u16* dst = kfull + ((size_t)(b * 8 + hd) * SEQ + s) * 96 + 64;
          unsigned o1[8], o2[8];
#pragma unroll
          for (int c = 0; c < 2; ++c) {
            uint4 u1 = *(const uint4*)(kr + c * 8), u2 = *(const uint4*)(kr + 16 + c * 8);
            unsigned a1[4] = {u1.x, u1.y, u1.z, u1.w}, a2[4] = {u2.x, u2.y, u2.z, u2.w};
#pragma unroll
            for (int j = 0; j < 4; ++j) {
              const int i0 = c * 8 + 2 * j;
              const float c0 = rp[i0], c1 = rp[i0 + 1], s0 = rp[16 + i0], s1 = rp[16 + i0 + 1];
              const float x1a = bflo(a1[j]), x1b = bfhi(a1[j]), x2a = bflo(a2[j]), x2b = bfhi(a2[j]);
              o1[c * 4 + j] = pk2(x1a * c0 - x2a * s0, x1b * c1 - x2b * s1);
              o2[c * 4 + j] = pk2(x1a * s0 + x2a * c0, x1b * s1 + x2b * c1);
            }
          }
          *(uint4*)(dst) = uint4{o1[0], o1[1], o1[2], o1[3]};
          *(uint4*)(dst + 8) = uint4{o1[4], o1[5], o1[6], o1[7]};
          *(uint4*)(dst + 16) = uint4{o2[0], o2[1], o2[2], o2[3]};
          *(uint4*)(dst + 24) = uint4{o2[4], o2[5], o2[6], o2[7]};
        }
      }
    } else if (sub == 2) {
      for (int v = rank; v < 512 + 512; v += nblk) {
        const int it = v;
        if (it < 512) {
          const int bh = it >> 4, qb = it & 15, b = bh >> 3, hd = bh & 7;
          mla_item_q64(qm + (size_t)b * SEQ * 768 + hd * 96, kfull + (size_t)bh * SEQ * 96, vt + (size_t)bh * 64 * SEQ,
                       oa + (size_t)b * SEQ * 512 + hd * 64, ropetab + (size_t)b * SEQ * 32, qb * 512, 0.10206207261596577f * LOG2E, smem);
        } else {
          const int i2 = it - 512;
          const int bp = i2 >> 5, qb = i2 & 31, b = bp >> 2, kvh = (bp >> 1) & 1, hq = kvh * 4 + (bp & 1) * 2;
          const float slA = exp2f(-(float)(hq + 1)) * LOG2E, slB = exp2f(-(float)(hq + 2)) * LOG2E;
          const float skA = p.in[9][layer * 8 + hq] * LOG2E, skB = p.in[9][layer * 8 + hq + 1] * LOG2E;
          gqa_item_pair(zs + (size_t)b * SEQ * ZS + 544 + hq * 64, zs + (size_t)b * SEQ * ZS + 1056 + kvh * 64,
                        vtc + (size_t)(b * 2 + kvh) * 64 * SEQ, oc + (size_t)b * SEQ * 512 + hq * 64, p.pos + b * SEQ, qb * 256,
                        0.125f * LOG2E, slA, slB, skA, skB, smem);
        }
      }
    } else if (sub == 3) {
      for (int it = bid; it < 4 * 4 * 32 * 4; it += nblk) {
        const int nt = it & 3, n2p = (it >> 2) & 31, g = (it >> 7) & 3, b = it >> 9;
        const u16* hb = hbuf + (size_t)b * SEQ * DM + g * 256;
        auto arow = [&](int m) { const int n2 = n2p * 2 + (m >> 7), n1 = m & 127; return hb + (size_t)(64 * n1 + n2) * DM; };
        f32x4 acc[4][4];
        zero_acc<4, 4>(acc);
        gemm_main<4, 4, false>(acc, arow, 0, E1, 256, nt * 128, 256, smem);
        gemm_epi<4, 4, false>(acc, 0, nt * 128, [&](int m, int n, f32x4 v, int, int) {
          const int n2 = n2p * 2 + (m >> 7), n1 = m & 127, comp = n >> 8, cp = n & 255;
          *(uint2*)(yt + ((((size_t)(b * 4 + g) * 256 + cp) * 64 + n2) * 2 + comp) * 128 + n1) = pk4(v);
        });
      }
    } else if (sub == 4) {
      {
        pg8::Order<1> S{1024, 1024, nblk, rank};
        pg8::gemm_phase((PG8_LAS unsigned char*)smem, pg8::Gemm{E2, yt, 256, 256, 256}, S, pg8::EpiE2{tp});
      }
    } else if (sub == 5) {
      for (int it = bid; it < 128 * 16; it += nblk) {
        const int k1 = it >> 4, m0 = (it & 15) * 256;
        f32x4 acc[4][2];
        zero_acc<4, 2>(acc);
        gemm_main<4, 2, false>(acc, RowLin{tp + (size_t)k1 * 128, 128 * 128}, m0, E3 + (size_t)k1 * 64 * 128, 128, 0, 128, smem);
        gemm_epi<4, 2, false>(acc, m0, 0, [&](int m, int n, f32x4 v, int, int) {
          const int b = m >> 10, g = (m >> 8) & 3, cp = m & 255;
          *(uint2*)(ob + ((size_t)b * SEQ + k1 + 128 * n) * DM + g * 256 + cp) = pk4(v);
        });
      }
    } else if (sub == 6) {
      {
        pg8::Order<4> S{12, 128 * 12, nblk, rank};
        pg8::gemm_phase((PG8_LAS unsigned char*)smem, pg8::Gemm{hbuf, W + W_IN + (size_t)ZS * 1024, DM, 1024, 1024}, S, pg8::EpiSigmoid{gbuf, 3072});
      }
    } else if (sub == 7) {
      for (int v = rank; v < 128 * 8; v += nblk) {
        int pm, pn; tile_of<4>(v, 8, pm, pn);
        const int m0 = pm * 256, n0 = pn * 128;
        f32x4 macc[4][4], acc[4][4];
        zero_acc<4, 4>(macc);
        const int tid_ = otid(), ln = tid_ & 63, wv = tid_ >> 6;
        const int wm = wv >> 1, wn = wv & 1;
#pragma unroll 1
        for (int br = 0; br < 3; ++br) {
          const u16* ab = br == 0 ? oa : (br == 1 ? ob : oc);
          const int lda = br == 1 ? 1024 : 512;
          const u16* wb = W + (br == 0 ? W_A : (br == 1 ? W_B : W_C));
          zero_acc<4, 4>(acc);
          uint2 gv[4][4];
#pragma unroll
          for (int i = 0; i < 4; ++i)
#pragma unroll
            for (int j = 0; j < 4; ++j) {
              const int m = m0 + wm * 64 + i * 16 + (ln & 15);
              const int n = n0 + wn * 64 + j * 16 + (ln >> 4) * 4;
              gv[i][j] = *(const uint2*)(gbuf + (size_t)m * 3072 + br * 1024 + n);
            }
          __builtin_amdgcn_sched_barrier(0);
          gemm_main<4, 4, true, false>(acc, RowLin{ab, lda}, m0, wb, lda, n0, lda, smem);
#pragma unroll
          for (int i = 0; i < 4; ++i)
#pragma unroll
            for (int j = 0; j < 4; ++j) {
              macc[i][j][0] += bflo(gv[i][j].x) * acc[i][j][0];
              macc[i][j][1] += bfhi(gv[i][j].x) * acc[i][j][1];
              macc[i][j][2] += bflo(gv[i][j].y) * acc[i][j][2];
              macc[i][j][3] += bfhi(gv[i][j].y) * acc[i][j][3];
            }
        }
#pragma unroll
        for (int i = 0; i < 4; ++i)
#pragma unroll
          for (int j = 0; j < 4; ++j) {
            const int m = m0 + wm * 64 + i * 16 + (ln & 15);
            const int n = n0 + wn * 64 + j * 16 + (ln >> 4) * 4;
            *(uint2*)(merged + (size_t)m * DM + n) = pk4(macc[i][j]);
          }
      }
    } else if (sub == 8) {
      {
        pg8::Order<8> S{4, 128 * 4, nblk, rank};
        pg8::gemm_phase((PG8_LAS unsigned char*)smem, pg8::Gemm{merged, W + W_OUT, DM, 1024, 1024}, S, pg8::EpiStore{ybuf, DM});
      }
    } else if (sub == 9) {
      const int wave = otid() >> 6;
      rowpass_pipe(bid * 8 + wave, nblk * 8, NTOK, x16, ybuf, p.in[14] + layer * DM, nullptr, x16, p.in[15] + layer * DM, hbuf);
    } else if (sub == 10) {
      {
        pg8::Order<4> S{22, 128 * 22, nblk, rank};
        pg8::gemm_phase((PG8_LAS unsigned char*)smem, pg8::Gemm{hbuf, W + W_FG, DM, 1024, 1024}, S, pg8::EpiSwiGLU{hid, FFN});
      }
    } else if (sub == 11) {
      {
        pg8::Order<8> S{4, 128 * 4, nblk, rank};
        pg8::gemm_phase((PG8_LAS unsigned char*)smem, pg8::Gemm{hid, W + W_FD, FFN, FFN, FFN}, S, pg8::EpiStore{ff, DM});
      }
    } else if (sub == 12) {
      const int wave = otid() >> 6;
      rowpass_pipe(bid * 8 + wave, nblk * 8, NTOK, x16, ff, p.in[19] + layer * DM, nullptr, nullptr, nullptr, hbuf);
    } else if (sub == 13) {
      for (int v = rank; v < 128 * 8; v += nblk) {
        int pm, pn; tile_of<4>(v, 8, pm, pn);
        const int m0 = pm * 256, n0 = pn * 128;
        f32x4 acc[4][4], acc2[4][4];
        zero_acc<4, 4>(acc);
        zero_acc<4, 4>(acc2);
        gemm_main<4, 4, true>(acc, RowLin{pb + (size_t)layer * NTOK * PLE, PLE}, m0, W + W_PLE, 256, n0, 256, smem);
        gemm_main<4, 4, true>(acc2, RowLin{hbuf, DM}, m0, W + W_PG, 1024, n0, 1024, smem);
        const int tid_ = otid(), ln = tid_ & 63, wv = tid_ >> 6;
        const int wm = wv >> 1, wn = wv & 1;
#pragma unroll
        for (int i = 0; i < 4; ++i)
#pragma unroll
          for (int j = 0; j < 4; ++j) {
            const int m = m0 + wm * 64 + i * 16 + (ln & 15);
            const int n = n0 + wn * 64 + j * 16 + (ln >> 4) * 4;
            f32x4 vv = acc[i][j], u = acc2[i][j], r;
#pragma unroll
            for (int q = 0; q < 4; ++q) r[q] = vv[q] * fsigmoid(u[q]);
            *(uint2*)(ebuf + (size_t)m * DM + n) = pk4(r);
          }
      }
    } else {
      const bool last = (layer == 1);
      const int wave = otid() >> 6;
      if (last) rowpass_pipe(bid * 8 + wave, nblk * 8, NTOK, hbuf, ebuf, p.in[22] + layer * DM, xout, nullptr, nullptr, nullptr);
      else rowpass_pipe(bid * 8 + wave, nblk * 8, NTOK, hbuf, ebuf, p.in[22] + layer * DM, nullptr, x16, p.in[3] + (layer + 1) * DM, hbuf);
    }
  }
}

extern "C" void kernel_launch(void* const* d_in, const int* in_sizes, int n_in, void* d_out, int out_size, void* d_ws, size_t ws_size,
                              hipStream_t stream) {
  static int grid = 0;
  if (grid == 0) {
    int dev = 0, cus = 0, per_cu = 0;
    (void)hipGetDevice(&dev);
    (void)hipDeviceGetAttribute(&cus, hipDeviceAttributeMultiprocessorCount, dev);
    if (hipFuncSetAttribute((const void*)mega, hipFuncAttributeMaxDynamicSharedMemorySize, LDS_BYTES) != hipSuccess) {
      fprintf(stderr, "hipFuncSetAttribute failed\n");
    }
    (void)hipOccupancyMaxActiveBlocksPerMultiprocessor(&per_cu, (const void*)mega, NTHR, LDS_BYTES);
    if (per_cu < 1) per_cu = 1;
    grid = cus * per_cu;
    if (ws_size < WS_NEED) fprintf(stderr, "workspace too small: %zu < %zu\n", ws_size, (size_t)WS_NEED);
    (void)hipGetLastError();
  }
  Params p{};
  for (int i = 0; i < 23; ++i) p.in[i] = (const float*)d_in[i];
  p.pos = (const int*)d_in[2];
  p.out = (float*)d_out;
  p.ws = (unsigned char*)d_ws;
  p.ph_lo = 0;
  p.ph_hi = 31;
  void* args[] = {&p};
  (void)hipMemsetAsync((char*)d_ws + OFF_CNT, 0, XB_WORDS * 4, stream);
  hipError_t e = hipLaunchCooperativeKernel((const void*)mega, dim3(grid), dim3(NTHR), args, LDS_BYTES, stream);
  if (e != hipSuccess) fprintf(stderr, "cooperative launch failed: %s (grid %d)\n", hipGetErrorString(e), grid);
}
```
